# Optimizing an MI355X kernel written in HIP

```python
import math
import jax, jax.numpy as jnp
from jax import lax
import numpy as np

D_MODEL = 1024
BATCH = 4
SEQ = 8192
DEPTH = 1

CHUNK = 64
EPS = 1e-6
PLE_DIM = 256
D_S5 = D_MODEL
S5_GROUP_CH = 16
S5_GROUPS = D_S5 // S5_GROUP_CH
S5_STATE = 64
D_SSD = D_MODEL
SSD_HEAD_DIM = 64
SSD_HEADS = D_SSD // SSD_HEAD_DIM
SSD_GROUPS = 4
SSD_HEADS_PER_GROUP = SSD_HEADS // SSD_GROUPS
SSD_STATE = 128
CONV_WIDTH = 4
SSD_CONV_DIM = D_SSD + 2 * SSD_GROUPS * SSD_STATE
NORM_GROUP = D_SSD // SSD_GROUPS
MIX_WIDTH = D_S5 + D_SSD
D_IN_PROJ = 2 * D_S5 + D_SSD + SSD_CONV_DIM + SSD_HEADS
SPLITS = (D_S5, 2 * D_S5, 2 * D_S5 + D_SSD, 2 * D_S5 + D_SSD + SSD_CONV_DIM)

kernel_name = "hybrid_s5_ssd_parallel_heads"


def rmsnorm(x, w):
    xf = x.astype(jnp.float32)
    y = xf * lax.rsqrt(jnp.mean(xf * xf, axis=-1, keepdims=True) + EPS)
    return (y * w.astype(jnp.float32)).astype(x.dtype)


def gated_group_rmsnorm(y, z, w):
    g = y.astype(jnp.float32) * jax.nn.silu(z.astype(jnp.float32))
    b, l, d = g.shape
    g = g.reshape(b, l, SSD_GROUPS, NORM_GROUP)
    g = g * lax.rsqrt(jnp.mean(g * g, axis=-1, keepdims=True) + EPS)
    return (g.reshape(b, l, d) * w.astype(jnp.float32)).astype(y.dtype)


def causal_depthwise_conv(x, w, bias):
    k_w = w.shape[0]
    L = x.shape[1]
    xp = jnp.pad(x, ((0, 0), (k_w - 1, 0), (0, 0)))
    return sum(xp[:, k:k + L] * w[k] for k in range(k_w)) + bias


def segsum(a):
    T = a.shape[-1]
    cs = jnp.cumsum(a, axis=-1)
    diff = cs[..., :, None] - cs[..., None, :]
    mask = jnp.tril(jnp.ones((T, T), dtype=bool))
    return jnp.where(mask, diff, -jnp.inf)


def s5_branch(u, A_re, A_im, log_dt, B_re, B_im, C_re, C_im, D, w_glu, b_glu):
    f32 = jnp.float32
    b, L, _ = u.shape
    n_chunks = L // CHUNK
    uf = u.astype(f32)
    u_c = uf.reshape(b, n_chunks, CHUNK, S5_GROUPS, S5_GROUP_CH).transpose(1, 0, 2, 3, 4)
    A = lax.complex(A_re.astype(f32), A_im.astype(f32))
    dt = jnp.exp(log_dt.astype(f32))[:, None]
    A_bar = jnp.exp(A * dt)
    Bc = lax.complex(B_re.astype(f32), B_im.astype(f32))
    B_bar = ((A_bar - 1.0) / A)[..., None] * Bc
    Cc = lax.complex(C_re.astype(f32), C_im.astype(f32))
    steps = jnp.arange(1, CHUNK + 1, dtype=f32)[:, None, None]
    pows = jnp.exp(A[None] * dt[None] * steps)

    def combine(e1, e2):
        a1, b1 = e1
        a2, b2 = e2
        return a1 * a2, a2 * b1 + b2

    def step(h0, uc):
        bu = jnp.einsum('btgh,gnh->btgn', uc, B_bar)
        a = jnp.broadcast_to(A_bar, bu.shape)
        _, local = lax.associative_scan(combine, (a, bu), axis=1)
        states = local + pows * h0[:, None]
        y = jnp.einsum('btgn,ghn->btgh', states, Cc).real
        return states[:, -1], y

    h0 = jnp.zeros((b, S5_GROUPS, S5_STATE), jnp.complex64)
    _, ys = lax.scan(step, h0, u_c)
    y = ys.transpose(1, 0, 2, 3, 4).reshape(b, L, D_S5) + D.astype(f32) * uf
    y = jax.nn.gelu(y)
    y = y * jax.nn.sigmoid(y @ w_glu.astype(f32) + b_glu.astype(f32))
    return y.astype(u.dtype)


def ssd_chunked(xs, dt, A, Bm, Cm):
    b, L, H, P = xs.shape
    c = L // CHUNK
    Bh = jnp.repeat(Bm, SSD_HEADS_PER_GROUP, axis=2).reshape(b, c, CHUNK, H, SSD_STATE)
    Ch = jnp.repeat(Cm, SSD_HEADS_PER_GROUP, axis=2).reshape(b, c, CHUNK, H, SSD_STATE)
    xd = (xs * dt[..., None]).reshape(b, c, CHUNK, H, P)
    a = (dt * A).reshape(b, c, CHUNK, H).transpose(0, 3, 1, 2)
    a_cs = jnp.cumsum(a, axis=-1)
    L_intra = jnp.exp(segsum(a))
    scores = jnp.einsum('bclhn,bcshn->bhcls', Ch, Bh) * L_intra
    y_diag = jnp.einsum('bhcls,bcshp->bclhp', scores, xd)
    decay_states = jnp.exp(a_cs[..., -1:] - a_cs)
    states = jnp.einsum('bclhn,bhcl,bclhp->bchpn', Bh, decay_states, xd)
    states = jnp.concatenate([jnp.zeros_like(states[:, :1]), states], axis=1)
    chunk_a = jnp.pad(a_cs[..., -1], ((0, 0), (0, 0), (1, 0)))
    decay_chunk = jnp.exp(segsum(chunk_a))
    new_states = jnp.einsum('bhzc,bchpn->bzhpn', decay_chunk, states)
    prev_states = new_states[:, :-1]
    y_off = jnp.einsum('bclhn,bchpn,bhcl->bclhp', Ch, prev_states, jnp.exp(a_cs))
    return (y_diag + y_off).reshape(b, L, H, P)


def ssd_branch(xBC, dt_raw, z, conv_w, conv_b, dt_bias, A_log, Dh, norm_w):
    f32 = jnp.float32
    b, L, _ = xBC.shape
    xBC = jax.nn.silu(causal_depthwise_conv(xBC, conv_w, conv_b))
    xs = xBC[..., :D_SSD].astype(f32).reshape(b, L, SSD_HEADS, SSD_HEAD_DIM)
    Bm = xBC[..., D_SSD:D_SSD + SSD_GROUPS * SSD_STATE].astype(f32).reshape(b, L, SSD_GROUPS, SSD_STATE)
    Cm = xBC[..., D_SSD + SSD_GROUPS * SSD_STATE:].astype(f32).reshape(b, L, SSD_GROUPS, SSD_STATE)
    dt = jax.nn.softplus(dt_raw.astype(f32) + dt_bias.astype(f32))
    A = -jnp.exp(A_log.astype(f32))
    y = ssd_chunked(xs, dt, A, Bm, Cm) + Dh.astype(f32)[:, None] * xs
    y = y.reshape(b, L, D_SSD).astype(z.dtype)
    return gated_group_rmsnorm(y, z, norm_w)


def setup_inputs(seed: int = 0) -> dict:
    key = jax.random.key(seed)
    ks = jax.random.split(key, 26)
    f32 = jnp.float32
    nrm = lambda k, s, sc: jax.random.normal(k, s, f32) * sc
    x = jax.random.normal(ks[0], (BATCH, SEQ, D_MODEL), f32)
    p = jax.random.normal(ks[1], (DEPTH, BATCH, SEQ, PLE_DIM), f32)
    norm_w = 1.0 + nrm(ks[2], (DEPTH, D_MODEL), 0.02)
    w_in = nrm(ks[3], (DEPTH, D_MODEL, D_IN_PROJ), D_MODEL ** -0.5)
    n_idx = jnp.arange(S5_STATE, dtype=f32)
    s5_A_re = -0.5 + nrm(ks[4], (DEPTH, S5_GROUPS, S5_STATE), 0.01)
    s5_A_im = math.pi * n_idx + nrm(ks[5], (DEPTH, S5_GROUPS, S5_STATE), 0.01)
    s5_log_dt = jax.random.uniform(ks[6], (DEPTH, S5_GROUPS), f32, math.log(1e-3), math.log(1e-1))
    s5_B_re = nrm(ks[7], (DEPTH, S5_GROUPS, S5_STATE, S5_GROUP_CH), (2 * S5_GROUP_CH) ** -0.5)
    s5_B_im = nrm(ks[8], (DEPTH, S5_GROUPS, S5_STATE, S5_GROUP_CH), (2 * S5_GROUP_CH) ** -0.5)
    s5_C_re = nrm(ks[9], (DEPTH, S5_GROUPS, S5_GROUP_CH, S5_STATE), (2 * S5_STATE) ** -0.5)
    s5_C_im = nrm(ks[10], (DEPTH, S5_GROUPS, S5_GROUP_CH, S5_STATE), (2 * S5_STATE) ** -0.5)
    s5_D = nrm(ks[11], (DEPTH, D_S5), 1.0)
    s5_w_glu = nrm(ks[12], (DEPTH, D_S5, D_S5), D_S5 ** -0.5)
    s5_b_glu = nrm(ks[13], (DEPTH, D_S5), 0.01)
    conv_w = nrm(ks[14], (DEPTH, CONV_WIDTH, SSD_CONV_DIM), CONV_WIDTH ** -0.5)
    conv_b = nrm(ks[15], (DEPTH, SSD_CONV_DIM), 0.01)
    dt0 = jnp.exp(jax.random.uniform(ks[16], (DEPTH, SSD_HEADS), f32, math.log(1e-3), math.log(1e-1)))
    dt_bias = dt0 + jnp.log(-jnp.expm1(-dt0))
    A_log = jnp.log(jax.random.uniform(ks[17], (DEPTH, SSD_HEADS), f32, 1.0, 16.0))
    ssd_D = 1.0 + nrm(ks[18], (DEPTH, SSD_HEADS), 0.1)
    ssd_norm_w = 1.0 + nrm(ks[19], (DEPTH, D_SSD), 0.02)
    w_out = nrm(ks[20], (DEPTH, MIX_WIDTH, D_MODEL), MIX_WIDTH ** -0.5)
    ple_norm_w = 1.0 + nrm(ks[21], (DEPTH, D_MODEL), 0.02)
    w_ple_gate = nrm(ks[22], (DEPTH, D_MODEL, D_MODEL), D_MODEL ** -0.5)
    w_ple_proj = nrm(ks[23], (DEPTH, PLE_DIM, D_MODEL), PLE_DIM ** -0.5)
    final_norm_w = 1.0 + nrm(ks[24], (D_MODEL,), 0.02)
    return {"x": x, "p": p, "norm_w": norm_w, "w_in": w_in,
            "s5_A_re": s5_A_re, "s5_A_im": s5_A_im, "s5_log_dt": s5_log_dt,
            "s5_B_re": s5_B_re, "s5_B_im": s5_B_im, "s5_C_re": s5_C_re, "s5_C_im": s5_C_im,
            "s5_D": s5_D, "s5_w_glu": s5_w_glu, "s5_b_glu": s5_b_glu,
            "conv_w": conv_w, "conv_b": conv_b, "dt_bias": dt_bias, "A_log": A_log,
            "ssd_D": ssd_D, "ssd_norm_w": ssd_norm_w, "w_out": w_out,
            "ple_norm_w": ple_norm_w, "w_ple_gate": w_ple_gate, "w_ple_proj": w_ple_proj,
            "final_norm_w": final_norm_w}


def reference(x, p, norm_w, w_in, s5_A_re, s5_A_im, s5_log_dt, s5_B_re, s5_B_im,
              s5_C_re, s5_C_im, s5_D, s5_w_glu, s5_b_glu, conv_w, conv_b, dt_bias,
              A_log, ssd_D, ssd_norm_w, w_out, ple_norm_w, w_ple_gate, w_ple_proj,
              final_norm_w):
    h = x
    for i in range(DEPTH):
        hn = rmsnorm(h, norm_w[i])
        proj = hn @ w_in[i]
        u_s5, z_s5, z_ssd, xBC, dt_raw = jnp.split(proj, SPLITS, axis=-1)
        y_s5 = s5_branch(u_s5, s5_A_re[i], s5_A_im[i], s5_log_dt[i], s5_B_re[i], s5_B_im[i],
                         s5_C_re[i], s5_C_im[i], s5_D[i], s5_w_glu[i], s5_b_glu[i])
        y_s5 = y_s5 * jax.nn.silu(z_s5)
        y_ssd = ssd_branch(xBC, dt_raw, z_ssd, conv_w[i], conv_b[i], dt_bias[i], A_log[i],
                           ssd_D[i], ssd_norm_w[i])
        h = h + jnp.concatenate([y_s5, y_ssd], axis=-1) @ w_out[i]
        gate = jax.nn.sigmoid(rmsnorm(h, ple_norm_w[i]) @ w_ple_gate[i])
        h = h + (p[i] @ w_ple_proj[i]) * gate
    return rmsnorm(h, final_norm_w)
```

```cpp
#include <hip/hip_runtime.h>
#include <cstdio>
#include <cstdint>

#ifndef MK_N_LAUNCHES
#define MK_N_LAUNCHES 1
#endif

#define LAS __attribute__((address_space(3)))
#define GAS __attribute__((address_space(1)))
typedef unsigned short bf16_t;
typedef short bf16x8 __attribute__((ext_vector_type(8)));
typedef float f32x4 __attribute__((ext_vector_type(4)));
typedef float f32x2 __attribute__((ext_vector_type(2)));
typedef unsigned u32x4 __attribute__((ext_vector_type(4)));
typedef unsigned u32x2 __attribute__((ext_vector_type(2)));

constexpr int NB = 4, SEQ = 8192, DM = 1024, M = NB * SEQ, NPROJ = 5136, PLE = 256;
constexpr int NCH = SEQ / 64;
constexpr int NSC = SEQ / 256;
constexpr size_t YPRE_OFF = 40 * (1u << 20);
constexpr int AUW = 1152;
constexpr float EPS = 1e-6f;
constexpr int NWAVES = 8, NTHR = 512;

constexpr size_t MiB = 1u << 20;
constexpr size_t WS_CTL   = 0;
constexpr size_t CTL_ZERO_BYTES = 1 * MiB;
constexpr size_t WS_WIN   = 1 * MiB;
constexpr size_t WS_WGLU  = 11 * MiB;
constexpr size_t WS_WOUT  = 13 * MiB;
constexpr size_t WS_WGATE = 17 * MiB;
constexpr size_t WS_WPLE  = 19 * MiB;
constexpr size_t WS_AB64  = 19 * MiB + 512 * 1024;
constexpr size_t WS_CD    = 19 * MiB + 576 * 1024;
constexpr size_t WS_SS1   = 20 * MiB;
constexpr size_t WS_SS2   = 22 * MiB;
constexpr size_t WS_RINV  = 23 * MiB;
constexpr size_t WS_DT    = 24 * MiB;
constexpr size_t WS_KR    = 26 * MiB;
constexpr size_t WS_Q     = 30 * MiB;
constexpr size_t WS_P     = 46 * MiB;
constexpr size_t WS_PB    = 62 * MiB;
constexpr size_t WS_S5S   = 78 * MiB;
constexpr size_t WS_XN    = 94 * MiB;
constexpr size_t WS_AU    = 158 * MiB;
constexpr size_t WS_ZZ    = 230 * MiB;
constexpr size_t WS_XBC   = 358 * MiB;
constexpr size_t WS_S5S2  = 486 * MiB;
constexpr size_t WS_END   = 502 * MiB;

constexpr int RING_BYTES = 131072, LDS_BYTES = 163840, LDSCTL_OFF = LDS_BYTES - 8192;

__device__ __forceinline__ float bf2f(unsigned short b) { return __uint_as_float((unsigned)b << 16); }
__device__ __forceinline__ float bflo(unsigned w) { return __uint_as_float(w << 16); }
__device__ __forceinline__ float bfhi(unsigned w) { return __uint_as_float(w & 0xffff0000u); }
__device__ __forceinline__ unsigned cvt_pk_bf16(float lo, float hi) { unsigned r; asm volatile("v_cvt_pk_bf16_f32 %0, %1, %2" : "=v"(r) : "v"(lo), "v"(hi)); return r; }
__device__ __forceinline__ unsigned short f2bf(float f) { return (unsigned short)(cvt_pk_bf16(f, 0.f) & 0xffffu); }
__device__ __forceinline__ float sigmoidf_(float x) { return __builtin_amdgcn_rcpf(1.f + __expf(-x)); }
__device__ __forceinline__ float siluf_(float x) { return x * sigmoidf_(x); }
__device__ __forceinline__ float gelu_tanh(float x) { const float u = 0.7978845608028654f * (x + 0.044715f * x * x * x); const float e = __expf(2.f * u); return x * (1.f - __builtin_amdgcn_rcpf(e + 1.f)); }
__device__ __forceinline__ float softplusf_(float x) { return x > 20.f ? x : log1pf(expf(x)); }
__device__ __forceinline__ float wave_sum(float v) {
#pragma unroll
    for (int o = 1; o < 64; o <<= 1) v += __shfl_xor(v, o);
    return v;
}

#define XB_TMO      128
#define XB_XCNT(j)  (256  + 64 * (j))
#define XB_XSUB(j)  (1280 + 64 * (j))
#define XB_XGEN(j)  (2304 + 64 * (j))
#define XB_TOP      3328
#define XB_TOPGEN   3392
#define XCD_BAR_WORDS 3456
#define XB_SPIN_CAP (1u << 18)
__device__ __forceinline__ unsigned xb_ld(unsigned* p)              { return __hip_atomic_load(p, __ATOMIC_RELAXED, __HIP_MEMORY_SCOPE_AGENT); }
__device__ __forceinline__ unsigned xb_add(unsigned* p, unsigned v) { return __hip_atomic_fetch_add(p, v, __ATOMIC_RELAXED, __HIP_MEMORY_SCOPE_AGENT); }
__device__ __forceinline__ unsigned xb_xcc_id() { return (unsigned)__builtin_amdgcn_s_getreg((3 << 11) | 20) & 0xFu; }
#define XB_SPIN(cond, bar) do { unsigned _sp = 0; while (cond) { __builtin_amdgcn_s_sleep(1); \
    if ((++_sp & 255u) == 0u) { if (xb_ld(&(bar)[XB_TMO])) break; if (_sp > XB_SPIN_CAP) { atomicAdd(&(bar)[XB_TMO], 1u); break; } } } } while (0)
struct XcdBarrier { unsigned* bar; unsigned x; volatile LAS unsigned* st; };
__device__ __forceinline__ XcdBarrier xcd_barrier_post(unsigned* bar, volatile LAS unsigned* st) {
    XcdBarrier b; b.bar = bar; b.x = xb_xcc_id(); b.st = st;
    if (threadIdx.x == 0) (void)xb_add(&bar[XB_XCNT(b.x)], 1u);
    return b;
}
__device__ __forceinline__ void xcd_barrier_complete(unsigned* bar, unsigned x, unsigned& nloc, unsigned& nx) {
    const unsigned G = gridDim.x * gridDim.y * gridDim.z;
    unsigned sum, cnt, mine, sp = 0u;
    for (;;) {
        sum = 0u; cnt = 0u; mine = 0u;
#pragma unroll
        for (unsigned j = 0; j < 16; ++j) { const unsigned c = xb_ld(&bar[XB_XCNT(j)]); sum += c; cnt += (c > 0u) ? 1u : 0u; mine = (j == x) ? c : mine; }
        if (sum == G) break;
        __builtin_amdgcn_s_sleep(1);
        if ((++sp & 255u) == 0u) { if (xb_ld(&bar[XB_TMO])) break; if (sp > XB_SPIN_CAP) { atomicAdd(&bar[XB_TMO], 1u); break; } }
    }
    nloc = mine > 0u ? mine : 1u; nx = cnt > 0u ? cnt : 1u;
}
__device__ __forceinline__ void xcd_barrier(const XcdBarrier& b) {
    asm volatile("s_waitcnt vmcnt(0)" ::: "memory");
    __syncthreads();
    if (threadIdx.x == 0) {
        unsigned* bar = b.bar;
        __builtin_amdgcn_s_waitcnt(0);
        unsigned nloc = b.st[0], nx = b.st[1];
        if (nloc == 0u) { xcd_barrier_complete(bar, b.x, nloc, nx); b.st[0] = nloc; b.st[1] = nx; }
        const unsigned old = xb_add(&bar[XB_XSUB(b.x)], 1u);
        const unsigned gen = old / nloc;
        if (old + 1u == (gen + 1u) * nloc) {
            __builtin_amdgcn_fence(__ATOMIC_RELEASE, "agent");
            asm volatile("s_waitcnt vmcnt(0)" ::: "memory");
            const unsigned og = xb_add(&bar[XB_TOP], 1u);
            const unsigned tg = og / nx;
            if (og + 1u == (tg + 1u) * nx) xb_add(&bar[XB_TOPGEN], 1u);
            else XB_SPIN(xb_ld(&bar[XB_TOPGEN]) == tg, bar);
            __builtin_amdgcn_fence(__ATOMIC_ACQUIRE, "agent");
            xb_add(&bar[XB_XGEN(b.x)], 1u);
            asm volatile("s_waitcnt vmcnt(0)" ::: "memory");
        } else {
            XB_SPIN(xb_ld(&bar[XB_XGEN(b.x)]) == gen, bar);
            __builtin_amdgcn_fence(__ATOMIC_ACQUIRE, "agent");
            asm volatile("s_waitcnt vmcnt(0)" ::: "memory");
        }
    }
    __syncthreads();
}

namespace pg8 {
constexpr int BM = 256, BK = 64, HALF = 128, HTB = HALF * BK * 2, NXCD = 8, WGM = 8;
__host__ __device__ __forceinline__ int lds_byte(int r, int c) { const int st = (r >> 4) * 2 + (c >> 5), rr = r & 15, cc = c & 31, ob = rr * 64 + cc * 2; return st * 1024 + (ob ^ (((ob >> 9) & 1) << 5)); }
__host__ __device__ __forceinline__ void stage_rc(int b, int& R, int& C) { const int st = b / 1024, sb = b % 1024, swz = sb ^ (((sb >> 9) & 1) << 5); R = (st >> 1) * 16 + swz / 64; C = (st & 1) * 32 + (swz % 64) / 2; }
__host__ __device__ __forceinline__ int perm32(int rho) { const int n = rho >> 4, i = rho & 15; return 8 * (i >> 2) + 4 * n + (i & 3); }

struct Unit { int pm, pn, g, nt; const char* a; const char* b; const char* bt; };

struct PlainOrder {
    int nM, nN, nwg, G, c, nt; const char* A; const char* B; long tsA, tsB;
    __device__ void init(int M_, int N_, int G_, int c_, const void* A_, long lda_b, const void* B_, long ldb_b, int nt_) {
        nM = M_ / BM; nN = N_ / BM; nwg = nM * nN; G = G_; c = c_; nt = nt_; A = (const char*)A_; B = (const char*)B_; tsA = 256 * lda_b; tsB = 256 * ldb_b; }
    __device__ bool next(int i, Unit& u) const {
        const long Lx = (long)i * G + c; if (Lx >= nwg) return false;
        int wgid = (int)Lx; { const int q = nwg / NXCD, r = nwg % NXCD, xcd = wgid % NXCD, off = wgid / NXCD; wgid = (xcd < r ? xcd * (q + 1) : r * (q + 1) + (xcd - r) * q) + off; }
        const int nig = WGM * nN, gid = wgid / nig, fm = gid * WGM, gsz = (nM - fm) < WGM ? (nM - fm) : WGM;
        u.pm = fm + ((wgid % nig) % gsz); u.pn = (wgid % nig) / gsz; u.g = 0; u.nt = nt;
        u.a = A + (long)u.pm * tsA; u.b = B + (long)u.pn * tsB; u.bt = u.b; return true;
    }
};

template <class Epi, class Sched, bool ALIGN_EPI, bool TOEP>
__device__ __forceinline__ void gemm_phase(LAS unsigned char* lds, const Sched& S, const Epi& E, const int lda_b, const int ldb_b) {
    const int tid = threadIdx.x, wid = __builtin_amdgcn_readfirstlane(tid >> 6), lane = tid & 63, wr = wid >> 2, wc = wid & 3, fr = lane & 15, fq = lane >> 4;
    unsigned voffA[2], voffB[2], voffT[2];
#pragma unroll
    for (int i = 0; i < 2; ++i) { int R, C; stage_rc(tid * 16 + i * 8192, R, C); const int Rb = Epi::PERM ? ((R & ~31) + perm32(R & 31)) : R;
        voffA[i] = (unsigned)(R * lda_b + C * 2); voffB[i] = (unsigned)(Rb * ldb_b + C * 2);
        voffT[i] = (unsigned)(((Rb & 15) * 2048 + (7 - (Rb >> 4)) * 16 + C) * 2); }
    const long kstep = BK * 2;
    const long hsA = (long)HALF * lda_b, hsBq = (long)HALF * ldb_b, hsBt = -256;
    const unsigned ldsw = (unsigned)wid * 1024u;
    const int aoff = lds_byte(wr * 64 + fr, fq * 8), boff = lds_byte(wc * 32 + fr, fq * 8);
#define PG8_SA(b, h) (((b) * 2 + (h)) * HTB)
#define PG8_SB(b, h) ((4 + (b) * 2 + (h)) * HTB)
#define PG8_STAGE2(bufoff, gbase, v0, v1) do { \
        __builtin_amdgcn_global_load_lds((const unsigned*)((const char*)(gbase) + (v0)), (LAS unsigned*)(lds + (bufoff) + ldsw), 16, 0, 0); \
        __builtin_amdgcn_global_load_lds((const unsigned*)((const char*)(gbase) + (v1)), (LAS unsigned*)(lds + (bufoff) + ldsw + 8192), 16, 0, 0); } while (0)
#define PG8_STAGEA(bufoff, gbase) PG8_STAGE2(bufoff, gbase, voffA[0], voffA[1])
#define PG8_LDA(dst, b, h) do { _Pragma("unroll") for (int m = 0; m < 4; ++m) _Pragma("unroll") for (int k = 0; k < 2; ++k) dst[m][k] = *(const LAS bf16x8*)(lds + PG8_SA(b, h) + aoff + m * 2048 + k * 1024); } while (0)
#define PG8_LDB(dst, b, h) do { _Pragma("unroll") for (int n = 0; n < 2; ++n) _Pragma("unroll") for (int k = 0; k < 2; ++k) dst[n][k] = *(const LAS bf16x8*)(lds + PG8_SB(b, h) + boff + n * 2048 + k * 1024); } while (0)
#define PG8_MMA(ai, bj, At, Bt) do { __builtin_amdgcn_s_setprio(1); _Pragma("unroll") for (int m = 0; m < 4; ++m) _Pragma("unroll") for (int n = 0; n < 2; ++n) _Pragma("unroll") for (int k = 0; k < 2; ++k) \
        acc[ai][bj][m][n] = __builtin_amdgcn_mfma_f32_16x16x32_bf16(Bt[n][k], At[m][k], acc[ai][bj][m][n], 0, 0, 0); __builtin_amdgcn_s_setprio(0); } while (0)
#define PG8_WAIT_V(n) asm volatile("s_waitcnt vmcnt(" #n ")" ::: "memory")
#define PG8_WAIT_L(n) asm volatile("s_waitcnt lgkmcnt(" #n ")" ::: "memory")
#define PG8_BAR __builtin_amdgcn_s_barrier()
#define PG8_SCHED __builtin_amdgcn_sched_barrier(0)
    Unit cur, nxt; int ui = 0;
    if (!S.next(0, cur)) return;
    f32x4 acc[2][2][4][2];
#pragma unroll
    for (int a = 0; a < 2; ++a)
#pragma unroll
        for (int b = 0; b < 2; ++b)
#pragma unroll
            for (int m = 0; m < 4; ++m)
#pragma unroll
                for (int n = 0; n < 2; ++n) acc[a][b][m][n] = (f32x4){0.f, 0.f, 0.f, 0.f};
    bf16x8 At[4][2], B0[2][2], B1[2][2];
    const char* cA = cur.a; const char* cB = cur.b; const char* cBt = cur.bt;
    PG8_STAGE2(PG8_SB(0, 0), cB, voffB[0], voffB[1]); PG8_STAGE2(PG8_SB(0, 1), cB + hsBq, voffB[0], voffB[1]); PG8_STAGEA(PG8_SA(0, 0), cA); PG8_STAGEA(PG8_SA(0, 1), cA + hsA);
    if (wr == 1) PG8_BAR;
    PG8_WAIT_V(2); PG8_BAR;
    PG8_STAGE2(PG8_SB(1, 0), cB + kstep, voffB[0], voffB[1]); PG8_STAGEA(PG8_SA(1, 0), cA + kstep); PG8_STAGE2(PG8_SB(1, 1), cB + hsBq + kstep, voffB[0], voffB[1]);
    PG8_WAIT_V(6); PG8_BAR;
    for (;;) {
        const bool has_next = S.next(ui + 1, nxt);
        const char* nA = has_next ? nxt.a : cA; const char* nB = has_next ? nxt.b : cB;
        const int nt = cur.nt;
        for (int t = 0; t < nt; t += 2) {
            const bool last = (t == nt - 2);
            const char* a1 = cA + (long)(t + 1) * kstep;
            const char* a2 = last ? nA : cA + (long)(t + 2) * kstep;
            const char* a3 = a2 + kstep;
            const char* b2; long hsB; unsigned vb0, vb1;
            if (TOEP) {
                if (last) { b2 = nB; hsB = hsBq; vb0 = voffB[0]; vb1 = voffB[1]; }
                else { b2 = cBt + (long)t * kstep; hsB = hsBt; vb0 = voffT[0]; vb1 = voffT[1]; }
            } else { b2 = last ? nB : cB + (long)(t + 2) * kstep; hsB = hsBq; vb0 = voffB[0]; vb1 = voffB[1]; }
            const char* b3 = b2 + kstep;
            PG8_LDB(B0, 0, 0); PG8_LDB(B1, 0, 1); PG8_SCHED; PG8_LDA(At, 0, 0); PG8_STAGEA(PG8_SA(1, 1), a1 + hsA);
            PG8_WAIT_V(8); PG8_WAIT_L(0); PG8_BAR; PG8_MMA(0, 0, At, B0); PG8_MMA(0, 1, At, B1); PG8_BAR; PG8_SCHED;
            PG8_LDA(At, 0, 1); PG8_STAGE2(PG8_SB(0, 0), b2, vb0, vb1); PG8_STAGE2(PG8_SB(0, 1), b2 + hsB, vb0, vb1); PG8_STAGEA(PG8_SA(0, 0), a2);
            PG8_WAIT_V(8); PG8_WAIT_L(0); PG8_BAR; PG8_MMA(1, 0, At, B0); PG8_MMA(1, 1, At, B1); PG8_BAR; PG8_SCHED;
            PG8_LDB(B0, 1, 0); PG8_LDB(B1, 1, 1); PG8_SCHED; PG8_LDA(At, 1, 0); PG8_STAGEA(PG8_SA(0, 1), a2 + hsA);
            PG8_WAIT_V(8); PG8_WAIT_L(0); PG8_BAR; PG8_MMA(0, 0, At, B0); PG8_MMA(0, 1, At, B1); PG8_BAR; PG8_SCHED;
            PG8_LDA(At, 1, 1); PG8_STAGE2(PG8_SB(1, 0), b3, vb0, vb1); PG8_STAGE2(PG8_SB(1, 1), b3 + hsB, vb0, vb1); PG8_STAGEA(PG8_SA(1, 0), a3);
            PG8_WAIT_V(8); PG8_WAIT_L(0); PG8_BAR; PG8_MMA(1, 0, At, B0); PG8_MMA(1, 1, At, B1); PG8_BAR; PG8_SCHED;
        }
        if constexpr (ALIGN_EPI) { if (wr == 0) PG8_BAR; }
        E(acc, cur, wr, wc, fr, fq);
        if (!has_next) break;
#pragma unroll
        for (int a = 0; a < 2; ++a)
#pragma unroll
            for (int b = 0; b < 2; ++b)
#pragma unroll
                for (int m = 0; m < 4; ++m)
#pragma unroll
                    for (int n = 0; n < 2; ++n) acc[a][b][m][n] = (f32x4){0.f, 0.f, 0.f, 0.f};
        cur = nxt; cA = nA; cB = nB; cBt = nxt.bt; ++ui;
        if constexpr (ALIGN_EPI) { if (wr == 1) PG8_BAR; }
    }
    PG8_WAIT_V(0);
    if constexpr (!ALIGN_EPI) { if (wr == 0) PG8_BAR; }
    PG8_BAR;
#undef PG8_SA
#undef PG8_SB
#undef PG8_STAGE2
#undef PG8_STAGEA
#undef PG8_LDA
#undef PG8_LDB
#undef PG8_MMA
#undef PG8_WAIT_V
#undef PG8_WAIT_L
#undef PG8_BAR
#undef PG8_SCHED
}

__device__ __forceinline__ u32x4 pack8(const f32x4 v0, const f32x4 v1) { u32x4 w; w.x = cvt_pk_bf16(v0[0], v0[1]); w.y = cvt_pk_bf16(v0[2], v0[3]); w.z = cvt_pk_bf16(v1[0], v1[1]); w.w = cvt_pk_bf16(v1[2], v1[3]); return w; }
__device__ __forceinline__ void unpack8(const u32x4 w, f32x4& a, f32x4& b) { a = (f32x4){bflo(w.x), bfhi(w.x), bflo(w.y), bfhi(w.y)}; b = (f32x4){bflo(w.z), bfhi(w.z), bflo(w.w), bfhi(w.w)}; }

struct EpiInProj {
    static constexpr bool PERM = true;
    bf16_t* AU; bf16_t* ZZ; bf16_t* XBC;
    __device__ __forceinline__ void operator()(const f32x4 (&acc)[2][2][4][2], const Unit& u, int wr, int wc, int fr, int fq) const {
        const int row0 = u.pm * BM + wr * 64 + fr, colt = u.pn * BM + wc * 32 + 8 * fq;
#pragma unroll
        for (int ai = 0; ai < 2; ++ai)
#pragma unroll
            for (int m = 0; m < 4; ++m) { const int row = row0 + ai * HALF + m * 16;
#pragma unroll
                for (int bj = 0; bj < 2; ++bj) { const int col = colt + bj * HALF; const u32x4 w = pack8(acc[ai][bj][m][0], acc[ai][bj][m][1]);
                    bf16_t* dst;
                    if (u.pn < 4) dst = AU + ((size_t)((col >> 4) * 512 + (row >> 6)) * AUW + 128 + (row & 63) * 16 + (col & 15));
                    else if (u.pn < 12) dst = ZZ + (size_t)row * 2048 + (col - 1024);
                    else dst = XBC + (size_t)row * 2048 + (col - 3072);
                    *(u32x4*)dst = w; } }
    }
};
struct EpiBf16 {
    static constexpr bool PERM = true;
    bf16_t* O; int ldc;
    __device__ __forceinline__ void operator()(const f32x4 (&acc)[2][2][4][2], const Unit& u, int wr, int wc, int fr, int fq) const {
        const int row0 = u.pm * BM + wr * 64 + fr, col0 = u.pn * BM + wc * 32 + 8 * fq;
#pragma unroll
        for (int ai = 0; ai < 2; ++ai)
#pragma unroll
            for (int m = 0; m < 4; ++m) { bf16_t* rowp = O + (size_t)(row0 + ai * HALF + m * 16) * ldc + col0;
#pragma unroll
                for (int bj = 0; bj < 2; ++bj) *(u32x4*)(rowp + bj * HALF) = pack8(acc[ai][bj][m][0], acc[ai][bj][m][1]); }
    }
};
struct EpiGlu {
    static constexpr bool PERM = true;
    const bf16_t* Y; bf16_t* ZZ; const float* bias;
    __device__ __forceinline__ void operator()(const f32x4 (&acc)[2][2][4][2], const Unit& u, int wr, int wc, int fr, int fq) const {
        const int row0 = u.pm * BM + wr * 64 + fr, col0 = u.pn * BM + wc * 32 + 8 * fq;
        f32x4 bv[2][2];
#pragma unroll
        for (int bj = 0; bj < 2; ++bj) { bv[bj][0] = *(const f32x4*)(bias + col0 + bj * HALF); bv[bj][1] = *(const f32x4*)(bias + col0 + bj * HALF + 4); }
#pragma unroll
        for (int ai = 0; ai < 2; ++ai) {
            u32x4 yw[4][2], zw[4][2];
#pragma unroll
            for (int m = 0; m < 4; ++m)
#pragma unroll
                for (int bj = 0; bj < 2; ++bj) { const size_t row = (size_t)(row0 + ai * HALF + m * 16); const int col = col0 + bj * HALF;
                    yw[m][bj] = *(const u32x4*)(Y + row * 1024 + col); zw[m][bj] = *(const u32x4*)(ZZ + row * 2048 + col); }
#pragma unroll
            for (int m = 0; m < 4; ++m)
#pragma unroll
                for (int bj = 0; bj < 2; ++bj) { const size_t row = (size_t)(row0 + ai * HALF + m * 16); const int col = col0 + bj * HALF;
                    f32x4 y0, y1, z0, z1; unpack8(yw[m][bj], y0, y1); unpack8(zw[m][bj], z0, z1);
                    const f32x4 a0 = acc[ai][bj][m][0] + bv[bj][0], a1 = acc[ai][bj][m][1] + bv[bj][1]; f32x4 o0, o1;
#pragma unroll
                    for (int e = 0; e < 4; ++e) { o0[e] = y0[e] * sigmoidf_(a0[e]) * siluf_(z0[e]); o1[e] = y1[e] * sigmoidf_(a1[e]) * siluf_(z1[e]); }
                    *(u32x4*)(ZZ + row * 2048 + col) = pack8(o0, o1); }
            asm volatile("" ::: "memory");
        }
    }
};
struct EpiOut {
    static constexpr bool PERM = true;
    const bf16_t* XN; const float* RINV; bf16_t* Hb; float* SS;
    __device__ __forceinline__ void operator()(const f32x4 (&acc)[2][2][4][2], const Unit& u, int wr, int wc, int fr, int fq) const {
        const int row0 = u.pm * BM + wr * 64 + fr, col0 = u.pn * BM + wc * 32 + 8 * fq;
#pragma unroll
        for (int ai = 0; ai < 2; ++ai) {
            u32x4 xw[4][2]; float ri[4];
#pragma unroll
            for (int m = 0; m < 4; ++m) { const size_t row = (size_t)(row0 + ai * HALF + m * 16); ri[m] = RINV[row];
#pragma unroll
                for (int bj = 0; bj < 2; ++bj) xw[m][bj] = *(const u32x4*)(XN + row * 1024 + col0 + bj * HALF); }
#pragma unroll
            for (int m = 0; m < 4; ++m) { const size_t row = (size_t)(row0 + ai * HALF + m * 16); float ss = 0.f;
#pragma unroll
                for (int bj = 0; bj < 2; ++bj) { const int col = col0 + bj * HALF;
                    f32x4 x0, x1; unpack8(xw[m][bj], x0, x1);
                    const f32x4 h0 = acc[ai][bj][m][0] + x0 * ri[m], h1 = acc[ai][bj][m][1] + x1 * ri[m];
                    *(u32x4*)(Hb + row * 1024 + col) = pack8(h0, h1);
                    ss += ((h0[0] * h0[0] + h0[1] * h0[1]) + (h0[2] * h0[2] + h0[3] * h0[3])) + ((h1[0] * h1[0] + h1[1] * h1[1]) + (h1[2] * h1[2] + h1[3] * h1[3])); }
                ss += __shfl_xor(ss, 16); ss += __shfl_xor(ss, 32);
                if (fq == 0) SS[row * 16 + u.pn * 4 + wc] = ss; }
            asm volatile("" ::: "memory");
        }
    }
};
struct EpiGate {
    static constexpr bool PERM = false;
    float* H; const bf16_t* Hb; const bf16_t* PL; const float* SS1; float* SS2;
    __device__ __forceinline__ void operator()(const f32x4 (&acc)[2][2][4][2], const Unit& u, int wr, int wc, int fr, int fq) const {
        const int row0 = u.pm * BM + wr * 64 + fr, col0 = u.pn * BM + wc * 32 + 4 * fq;
#pragma unroll
        for (int ai = 0; ai < 2; ++ai)
#pragma unroll
            for (int m = 0; m < 4; ++m) { const size_t row = (size_t)(row0 + ai * HALF + m * 16);
                const f32x4 s0 = *(const f32x4*)(SS1 + row * 16), s1 = *(const f32x4*)(SS1 + row * 16 + 4), s2 = *(const f32x4*)(SS1 + row * 16 + 8), s3 = *(const f32x4*)(SS1 + row * 16 + 12);
                const f32x4 st = (s0 + s1) + (s2 + s3);
                const float r = rsqrtf(((st[0] + st[1]) + (st[2] + st[3])) * (1.f / 1024.f) + EPS);
                float ss = 0.f;
#pragma unroll
                for (int bj = 0; bj < 2; ++bj)
#pragma unroll
                    for (int n = 0; n < 2; ++n) { const int col = col0 + bj * HALF + n * 16;
                        const u32x2 hw = *(const u32x2*)(Hb + row * 1024 + col); const f32x4 h = (f32x4){bflo(hw.x), bfhi(hw.x), bflo(hw.y), bfhi(hw.y)}; const u32x2 pw = *(const u32x2*)(PL + row * 1024 + col);
                        const f32x4 pl = (f32x4){bflo(pw.x), bfhi(pw.x), bflo(pw.y), bfhi(pw.y)}; const f32x4 a = acc[ai][bj][m][n] * r; f32x4 o;
#pragma unroll
                        for (int e = 0; e < 4; ++e) o[e] = h[e] + pl[e] * sigmoidf_(a[e]);
                        *(f32x4*)(H + row * 1024 + col) = o;
                        ss += (o[0] * o[0] + o[1] * o[1]) + (o[2] * o[2] + o[3] * o[3]); }
                ss += __shfl_xor(ss, 16); ss += __shfl_xor(ss, 32);
                if (fq == 0) SS2[row * 16 + u.pn * 4 + wc] = ss;
                if (m & 1) asm volatile("" ::: "memory"); }
    }
};

struct EpiGateFinal {
    static constexpr bool PERM = true;
    float* OUT; const bf16_t* Hb; const bf16_t* PL; const float* SS1; float* XS; unsigned* cnt; const float* fw; LAS unsigned char* lx;
    __device__ __forceinline__ void operator()(f32x4 (&acc)[2][2][4][2], const Unit& u, int wr, int wc, int fr, int fq) const {
        const int tid = threadIdx.x, lane = tid & 63, wid = __builtin_amdgcn_readfirstlane(tid >> 6);
        LAS float* P = (LAS float*)(lx + 1024);
        LAS float* S = (LAS float*)(lx + 1024 + 4096);
        const int row0 = u.pm * BM + wr * 64 + fr, col0 = u.pn * BM + wc * 32 + 8 * fq;
#pragma unroll
        for (int ai = 0; ai < 2; ++ai) {
            f32x4 sq[4]; u32x4 hw[4][2], pw[4][2];
#pragma unroll
            for (int m = 0; m < 4; ++m) { const size_t row = (size_t)(row0 + ai * HALF + m * 16); sq[m] = *(const f32x4*)(SS1 + row * 16 + 4 * fq);
#pragma unroll
                for (int bj = 0; bj < 2; ++bj) { hw[m][bj] = *(const u32x4*)(Hb + row * 1024 + col0 + bj * HALF); pw[m][bj] = *(const u32x4*)(PL + row * 1024 + col0 + bj * HALF); } }
#pragma unroll
            for (int m = 0; m < 4; ++m) {
                float st = (sq[m][0] + sq[m][1]) + (sq[m][2] + sq[m][3]); st += __shfl_xor(st, 16); st += __shfl_xor(st, 32);
                const float r = rsqrtf(st * (1.f / 1024.f) + EPS);
                float ss = 0.f;
#pragma unroll
                for (int bj = 0; bj < 2; ++bj) {
                    f32x4 hh[2], pl[2]; unpack8(hw[m][bj], hh[0], hh[1]); unpack8(pw[m][bj], pl[0], pl[1]);
#pragma unroll
                    for (int n = 0; n < 2; ++n) { const f32x4 a = acc[ai][bj][m][n] * r; f32x4 o;
#pragma unroll
                        for (int e = 0; e < 4; ++e) o[e] = hh[n][e] + pl[n][e] * sigmoidf_(a[e]);
                        acc[ai][bj][m][n] = o;
                        ss += (o[0] * o[0] + o[1] * o[1]) + (o[2] * o[2] + o[3] * o[3]); } }
                ss += __shfl_xor(ss, 16); ss += __shfl_xor(ss, 32);
                if (fq == 0) P[(ai * HALF + wr * 64 + m * 16 + fr) * 4 + wc] = ss; }
            asm volatile("" ::: "memory");
        }
        asm volatile("s_waitcnt lgkmcnt(0)" ::: "memory"); __builtin_amdgcn_s_barrier(); asm volatile("" ::: "memory");
        if (tid < 256) { const f32x4 p4 = *(const LAS f32x4*)(P + tid * 4);
            __hip_atomic_store(XS + (size_t)(u.pm * BM + tid) * 4 + u.pn, (p4[0] + p4[1]) + (p4[2] + p4[3]), __ATOMIC_RELAXED, __HIP_MEMORY_SCOPE_AGENT); }
        asm volatile("s_waitcnt vmcnt(0)" ::: "memory");
        if (tid < 256 && lane == 0) __hip_atomic_fetch_add(cnt + 64 * u.pm, 1u, __ATOMIC_RELAXED, __HIP_MEMORY_SCOPE_AGENT);
        if (wid == 0) {
            unsigned sp = 0;
            while ((unsigned)__builtin_amdgcn_readfirstlane(__hip_atomic_load(cnt + 64 * u.pm, __ATOMIC_RELAXED, __HIP_MEMORY_SCOPE_AGENT)) < 16u) { __builtin_amdgcn_s_sleep(2); if (++sp > (1u << 22)) break; }
            __builtin_amdgcn_fence(__ATOMIC_ACQUIRE, "agent");
        }
        asm volatile("s_waitcnt vmcnt(0) lgkmcnt(0)" ::: "memory"); __builtin_amdgcn_s_barrier(); asm volatile("" ::: "memory");
        if (tid < 256) { const float* xs = XS + (size_t)(u.pm * BM + tid) * 4; float t = 0.f;
#pragma unroll
            for (int k = 0; k < 4; ++k) t += __hip_atomic_load(xs + k, __ATOMIC_RELAXED, __HIP_MEMORY_SCOPE_AGENT);
            S[tid] = rsqrtf(t * (1.f / 1024.f) + EPS); }
        asm volatile("s_waitcnt vmcnt(0) lgkmcnt(0)" ::: "memory"); __builtin_amdgcn_s_barrier(); asm volatile("" ::: "memory");
        f32x4 wv[2][2];
#pragma unroll
        for (int bj = 0; bj < 2; ++bj)
#pragma unroll
            for (int n = 0; n < 2; ++n) wv[bj][n] = *(const f32x4*)(fw + col0 + bj * HALF + n * 4);
#pragma unroll
        for (int ai = 0; ai < 2; ++ai)
#pragma unroll
            for (int m = 0; m < 4; ++m) { const int rl = ai * HALF + wr * 64 + m * 16 + fr; const float r2 = S[rl]; const size_t row = (size_t)(u.pm * BM + rl);
#pragma unroll
                for (int bj = 0; bj < 2; ++bj)
#pragma unroll
                    for (int n = 0; n < 2; ++n) *(f32x4*)(OUT + row * 1024 + col0 + bj * HALF + n * 4) = acc[ai][bj][m][n] * r2 * wv[bj][n]; }
    }
};

struct S5SOrder {
    int c; const char* AU; const char* P;
    __device__ bool next(int i, Unit& u) const {
        if (i != 0 || c >= 256) return false;
        const int g = c >> 2, pm = (c >> 1) & 1, kh = c & 1;
        u.pm = pm; u.pn = kh; u.g = g; u.nt = 8;
        u.a = AU + ((size_t)(g * 512 + pm * 256) * AUW + 128 + kh * 512) * 2; u.b = P + ((size_t)g * 128 * 1024 + kh * 512) * 2; u.bt = u.b; return true;
    }
};
struct EpiS5S {
    static constexpr bool PERM = false;
    float* S0; long half_stride;
    __device__ __forceinline__ void operator()(const f32x4 (&acc)[2][2][4][2], const Unit& u, int wr, int wc, int fr, int fq) const {
        float* S = S0 + (long)u.pn * half_stride + (size_t)(u.g * 512 + u.pm * 256) * 128;
        const int row0 = wr * 64 + fr, col0 = wc * 32 + 4 * fq;
#pragma unroll
        for (int ai = 0; ai < 2; ++ai)
#pragma unroll
            for (int m = 0; m < 4; ++m)
#pragma unroll
                for (int n = 0; n < 2; ++n) *(f32x4*)(S + (size_t)(row0 + ai * HALF + m * 16) * 128 + col0 + n * 16) = acc[ai][0][m][n];
    }
};
struct S5YOrder {
    int c; const char* AU; const char* Q; const char* KR;
    __device__ bool next(int i, Unit& u) const {
        if (i > 1 || c >= 256) return false;
        const int x = c & 7, k = c >> 3, lt = k >> 2;
        const int g = (x + 8 * (lt >> 2)) * 4 + (k & 3), pm = lt & 1, pair = (lt >> 1) & 1;
        const int pn = pair ? (i == 0 ? 1 : 2) : (i == 0 ? 0 : 3);
        u.pm = pm; u.pn = pn; u.g = g; u.nt = 4 * pn + 6;
        u.a = AU + (size_t)(g * 512 + pm * 256) * AUW * 2;
        u.b = Q + ((size_t)g * 1024 + pn * 256) * 128 * 2;
        u.bt = KR + (size_t)g * 65536 + (896 - pn * 256) * 2;
        return true;
    }
};
struct EpiS5Y {
    static constexpr bool PERM = true;
    bf16_t* Y;
    __device__ __forceinline__ void operator()(const f32x4 (&acc)[2][2][4][2], const Unit& u, int wr, int wc, int fr, int fq) const {
        const int row0 = u.pm * BM + wr * 64 + fr, col0 = u.pn * BM + wc * 32 + 8 * fq;
        const int h0 = col0 & 15;
#pragma unroll
        for (int ai = 0; ai < 2; ++ai)
#pragma unroll
            for (int m = 0; m < 4; ++m) { const int bc = row0 + ai * HALF + m * 16;
#pragma unroll
                for (int bj = 0; bj < 2; ++bj) { const int col = col0 + bj * HALF, t = col >> 4; f32x4 o0, o1;
#pragma unroll
                    for (int e = 0; e < 4; ++e) { o0[e] = gelu_tanh(acc[ai][bj][m][0][e]); o1[e] = gelu_tanh(acc[ai][bj][m][1][e]); }
                    *(u32x4*)(Y + (size_t)(bc * 64 + t) * 1024 + u.g * 16 + h0) = pack8(o0, o1); } }
    }
};
}

struct Args { const float* in[25]; float* out; unsigned char* ws; int ph_lo, ph_hi; };
enum { I_X = 0, I_P, I_NORMW, I_WIN, I_ARE, I_AIM, I_LOGDT, I_BRE, I_BIM, I_CRE, I_CIM, I_S5D, I_WGLU, I_BGLU, I_CONVW, I_CONVB, I_DTBIAS, I_ALOG, I_SSDD, I_SSDNW, I_WOUT, I_PLENW, I_WGATE, I_WPLE, I_FINALW };
constexpr int N_PHASES = 8;
#ifndef DBL_PHASE
#define DBL_PHASE -1
#endif

__device__ __forceinline__ void p0_transpose_item(const float* W, int ldw, int K, int N, bf16_t* WT, const float* sc, LAS float* scr, int item, int lane) {
    const int nblk = N / 32, kb = item / nblk, nb = item % nblk, k0 = 64 * kb, n0 = 32 * nb;
    float v[32];
#pragma unroll
    for (int i = 0; i < 32; ++i) v[i] = W[(size_t)(k0 + 2 * i + (lane >> 5)) * ldw + n0 + (lane & 31)];
    if (sc) {
        float s2[32];
#pragma unroll
        for (int i = 0; i < 32; ++i) s2[i] = sc[k0 + 2 * i + (lane >> 5)];
#pragma unroll
        for (int i = 0; i < 32; ++i) v[i] *= s2[i];
    }
#pragma unroll
    for (int i = 0; i < 32; ++i) scr[(2 * i + (lane >> 5)) * 33 + (lane & 31)] = v[i];
    asm volatile("s_waitcnt lgkmcnt(0)" ::: "memory");
    const int c = lane & 7;
#pragma unroll
    for (int j = 0; j < 4; ++j) { const int n = (lane >> 3) + 8 * j; const LAS float* s = scr + (8 * c) * 33 + n;
        u32x4 o; o.x = cvt_pk_bf16(s[0 * 33], s[1 * 33]); o.y = cvt_pk_bf16(s[2 * 33], s[3 * 33]); o.z = cvt_pk_bf16(s[4 * 33], s[5 * 33]); o.w = cvt_pk_bf16(s[6 * 33], s[7 * 33]);
        *(u32x4*)(WT + (size_t)(n0 + n) * K + k0 + 8 * c) = o; }
    asm volatile("s_waitcnt lgkmcnt(0)" ::: "memory");
}

__device__ __forceinline__ void p0_prologue(const Args& a, LAS unsigned char* lds, int vcu, int G) {
    const int tid = threadIdx.x, lane = tid & 63, wave = __builtin_amdgcn_readfirstlane(tid >> 6);
    unsigned char* ws = a.ws;
    for (int blk = vcu; blk < 256; blk += G) {
        const int g = blk >> 2, q = blk & 3;
        LAS float* PWr = (LAS float*)lds;
        LAS float* PWi = PWr + 65 * 64;
        LAS float* Cr = PWi + 65 * 64;
        LAS float* Ci = Cr + 1024;
        LAS float* Br = Ci + 1024;
        LAS float* Bi = Br + 1024;
        const float dt = expf(a.in[I_LOGDT][g]);
        { const int n = tid & 63; const float are = a.in[I_ARE][g * 64 + n] * dt, aim = a.in[I_AIM][g * 64 + n] * dt;
#pragma unroll
            for (int i = 0; i < 9; ++i) { const int tau = (tid >> 6) + 8 * i; if (tau < 65) {
                const float mag = __expf(are * (float)tau); const float ang = aim * (float)tau; const float sn = __sinf(ang), cs = __cosf(ang);
                PWr[tau * 64 + n] = mag * cs; PWi[tau * 64 + n] = mag * sn; } } }
        for (int e = tid; e < 1024; e += NTHR) { const int h = e >> 6, n = e & 63; Cr[e] = a.in[I_CRE][(g * 16 + h) * 64 + n]; Ci[e] = a.in[I_CIM][(g * 16 + h) * 64 + n]; }
        for (int e = tid; e < 1024; e += NTHR) { const int n = e >> 4;
            const float are = a.in[I_ARE][g * 64 + n], aim = a.in[I_AIM][g * 64 + n];
            const float mag = expf(are * dt); float sn, cs; sincosf(aim * dt, &sn, &cs);
            const float nr = mag * cs - 1.f, ni = mag * sn, den = are * are + aim * aim;
            const float qr = (nr * are + ni * aim) / den, qi = (ni * are - nr * aim) / den;
            const float br = a.in[I_BRE][g * 1024 + e], bi = a.in[I_BIM][g * 1024 + e];
            Br[e] = qr * br - qi * bi; Bi[e] = qr * bi + qi * br; }
        __syncthreads();
        {
            const int tau = 16 * q + (tid >> 5), h = (tid >> 1) & 15, hp0 = (tid & 1) * 8;
            float s[8];
#pragma unroll
            for (int j = 0; j < 8; ++j) s[j] = 0.f;
            for (int n = 0; n < 64; ++n) { const float pr = PWr[tau * 64 + n], pi = PWi[tau * 64 + n], cr = Cr[h * 64 + n], ci = Ci[h * 64 + n];
                const float xr = cr * pr - ci * pi, xi = cr * pi + ci * pr;
#pragma unroll
                for (int j = 0; j < 8; ++j) s[j] += xr * Br[n * 16 + hp0 + j] - xi * Bi[n * 16 + hp0 + j]; }
            if (tau == 0) { const float dv = a.in[I_S5D][g * 16 + h];
#pragma unroll
                for (int j = 0; j < 8; ++j) if (hp0 + j == h) s[j] += dv; }
            bf16_t* KR = (bf16_t*)(ws + WS_KR) + (size_t)g * 32768 + (size_t)h * 2048 + (63 - tau) * 16 + hp0;
            u32x4 o; o.x = cvt_pk_bf16(s[0], s[1]); o.y = cvt_pk_bf16(s[2], s[3]); o.z = cvt_pk_bf16(s[4], s[5]); o.w = cvt_pk_bf16(s[6], s[7]);
            *(u32x4*)KR = o;
            bf16_t* KZ = (bf16_t*)(ws + WS_KR) + (size_t)g * 32768 + (size_t)(tid >> 5) * 2048 + (64 + 16 * q) * 16 + (tid & 31) * 8;
            *(u32x4*)KZ = (u32x4){0u, 0u, 0u, 0u};
        }
        {
            const int t = 16 * q + (tid >> 5), h = (tid >> 1) & 15, kh = tid & 1;
            bf16_t* QP = (bf16_t*)(ws + WS_Q) + ((size_t)g * 1024 + t * 16 + h) * 128 + kh * 64;
#pragma unroll 2
            for (int n0 = 0; n0 < 64; n0 += 8) { float v[8];
#pragma unroll
                for (int j = 0; j < 8; ++j) { const int n = n0 + j; const float pr = PWr[(t + 1) * 64 + n], pi = PWi[(t + 1) * 64 + n], cr = Cr[h * 64 + n], ci = Ci[h * 64 + n];
                    v[j] = kh ? -(cr * pi + ci * pr) : (cr * pr - ci * pi); }
                u32x4 o; o.x = cvt_pk_bf16(v[0], v[1]); o.y = cvt_pk_bf16(v[2], v[3]); o.z = cvt_pk_bf16(v[4], v[5]); o.w = cvt_pk_bf16(v[6], v[7]);
                *(u32x4*)(QP + n0) = o; }
        }
        {
            const int np = tid >> 2, n = np & 63, im = np >> 6, s0 = 16 * q + (tid & 3) * 4;
            bf16_t* PP = (bf16_t*)(ws + WS_P) + ((size_t)g * 128 + np) * 1024 + s0 * 16;
#pragma unroll
            for (int ds = 0; ds < 4; ++ds) { const int s = s0 + ds; const float pr = PWr[(63 - s) * 64 + n], pi = PWi[(63 - s) * 64 + n]; float v[16];
#pragma unroll
                for (int j = 0; j < 16; ++j) { const float br = Br[n * 16 + j], bi = Bi[n * 16 + j]; v[j] = im ? (pr * bi + pi * br) : (pr * br - pi * bi); }
                u32x4 o0, o1; o0.x = cvt_pk_bf16(v[0], v[1]); o0.y = cvt_pk_bf16(v[2], v[3]); o0.z = cvt_pk_bf16(v[4], v[5]); o0.w = cvt_pk_bf16(v[6], v[7]);
                o1.x = cvt_pk_bf16(v[8], v[9]); o1.y = cvt_pk_bf16(v[10], v[11]); o1.z = cvt_pk_bf16(v[12], v[13]); o1.w = cvt_pk_bf16(v[14], v[15]);
                *(u32x4*)(PP + ds * 16) = o0; *(u32x4*)(PP + ds * 16 + 8) = o1; }
        }
        if (q == 0 && tid < 64) { float* AB = (float*)(ws + WS_AB64) + (g * 64 + tid) * 2; AB[0] = PWr[64 * 64 + tid]; AB[1] = PWi[64 * 64 + tid]; }
        __syncthreads();
    }
    LAS float* WD = (LAS float*)lds;
    {
        f32x4 wr_[2][4]; float nw_[2];
#pragma unroll
        for (int i = 0; i < 2; ++i) { const int k = tid + 512 * i; nw_[i] = a.in[I_NORMW][k];
#pragma unroll
            for (int c = 0; c < 4; ++c) wr_[i][c] = *(const f32x4*)(a.in[I_WIN] + (size_t)k * NPROJ + 5120 + 4 * c); }
#pragma unroll
        for (int i = 0; i < 2; ++i) { const int k = tid + 512 * i;
#pragma unroll
            for (int c = 0; c < 4; ++c) *(LAS f32x4*)(WD + ((((k >> 8) * 4 + (k & 3)) * 4 + c) * 64 + ((k >> 2) & 63)) * 4) = wr_[i][c] * nw_[i]; }
    }
    __syncthreads();
    if (wave >= 6) {
        LAS float* scr = (LAS float*)(lds + 65536 + (wave - 6) * 16384);
        const int gw = vcu * 2 + (wave - 6), NGW = G * 2;
        constexpr int I_IN = 16 * 160, I_GL = 16 * 32, I_OU = 32 * 32, I_GA = 16 * 32, I_PL = 4 * 32, NIT = I_IN + I_GL + I_OU + I_GA + I_PL;
        for (int it = gw; it < NIT; it += NGW) {
            int r = it;
            if (r < I_IN) { p0_transpose_item(a.in[I_WIN], NPROJ, 1024, 5120, (bf16_t*)(ws + WS_WIN), a.in[I_NORMW], scr, r, lane); continue; } r -= I_IN;
            if (r < I_GL) { p0_transpose_item(a.in[I_WGLU], 1024, 1024, 1024, (bf16_t*)(ws + WS_WGLU), nullptr, scr, r, lane); continue; } r -= I_GL;
            if (r < I_OU) { p0_transpose_item(a.in[I_WOUT], 1024, 2048, 1024, (bf16_t*)(ws + WS_WOUT), nullptr, scr, r, lane); continue; } r -= I_OU;
            if (r < I_GA) { p0_transpose_item(a.in[I_WGATE], 1024, 1024, 1024, (bf16_t*)(ws + WS_WGATE), a.in[I_PLENW], scr, r, lane); continue; } r -= I_GA;
            p0_transpose_item(a.in[I_WPLE], 1024, 256, 1024, (bf16_t*)(ws + WS_WPLE), nullptr, scr, r, lane);
        }
    } else {
        const int gw = vcu * 6 + wave, NGW = G * 6;
        const float* X = a.in[I_X]; bf16_t* XN = (bf16_t*)(ws + WS_XN); float* DT = (float*)(ws + WS_DT);
        const float bias = a.in[I_DTBIAS][lane >> 2];
        f32x4 vn[4];
        if (gw < M) {
#pragma unroll
            for (int j = 0; j < 4; ++j) vn[j] = *((const f32x4*)(X + (size_t)gw * DM) + lane + 64 * j); }
        for (int m = gw; m < M; m += NGW) {
            f32x4 v[4]; float s = 0.f;
#pragma unroll
            for (int j = 0; j < 4; ++j) { v[j] = vn[j]; s += (v[j][0] * v[j][0] + v[j][1] * v[j][1]) + (v[j][2] * v[j][2] + v[j][3] * v[j][3]); }
            if (m + NGW < M) {
#pragma unroll
                for (int j = 0; j < 4; ++j) vn[j] = *((const f32x4*)(X + (size_t)(m + NGW) * DM) + lane + 64 * j); }
            const float ms = wave_sum(s) * (1.f / DM) + EPS; const float r = rsqrtf(ms);
            if (lane == 0) ((float*)(ws + WS_RINV))[m] = sqrtf(ms);
            u32x2* o8 = (u32x2*)(XN + (size_t)m * DM) + lane;
            float d[16];
#pragma unroll
            for (int h = 0; h < 16; ++h) d[h] = 0.f;
#pragma unroll
            for (int j = 0; j < 4; ++j) { v[j] = v[j] * r; u32x2 w; w.x = cvt_pk_bf16(v[j][0], v[j][1]); w.y = cvt_pk_bf16(v[j][2], v[j][3]); o8[64 * j] = w;
#pragma unroll
                for (int e = 0; e < 4; ++e)
#pragma unroll
                    for (int c = 0; c < 4; ++c) { const f32x4 wv = *(const LAS f32x4*)(WD + (((j * 4 + e) * 4 + c) * 64 + lane) * 4);
                        d[4 * c + 0] += v[j][e] * wv[0]; d[4 * c + 1] += v[j][e] * wv[1]; d[4 * c + 2] += v[j][e] * wv[2]; d[4 * c + 3] += v[j][e] * wv[3]; } }
            const bool b5 = lane & 32, b4 = lane & 16, b3 = lane & 8, b2 = lane & 4;
            float r8[8], r4[4], r2[2], r1;
#pragma unroll
            for (int i = 0; i < 8; ++i) { const float keep = b5 ? d[i + 8] : d[i], send = b5 ? d[i] : d[i + 8]; r8[i] = keep + __shfl_xor(send, 32); }
#pragma unroll
            for (int i = 0; i < 4; ++i) { const float keep = b4 ? r8[i + 4] : r8[i], send = b4 ? r8[i] : r8[i + 4]; r4[i] = keep + __shfl_xor(send, 16); }
#pragma unroll
            for (int i = 0; i < 2; ++i) { const float keep = b3 ? r4[i + 2] : r4[i], send = b3 ? r4[i] : r4[i + 2]; r2[i] = keep + __shfl_xor(send, 8); }
            { const float keep = b2 ? r2[1] : r2[0], send = b2 ? r2[0] : r2[1]; r1 = keep + __shfl_xor(send, 4); }
            r1 += __shfl_xor(r1, 2); r1 += __shfl_xor(r1, 1);
            if ((lane & 3) == 0) DT[(size_t)m * 16 + (lane >> 2)] = softplusf_(r1 + bias);
        }
    }
    {
        const int gw = vcu * NWAVES + wave, NGW = G * NWAVES;
        const float* Pp = a.in[I_P]; bf16_t* PB = (bf16_t*)(ws + WS_PB);
        for (int m0 = gw; m0 < M; m0 += 8 * NGW) { f32x4 pv[8];
#pragma unroll
            for (int i = 0; i < 8; ++i) pv[i] = *((const f32x4*)(Pp + (size_t)(m0 + i * NGW) * PLE) + lane);
#pragma unroll
            for (int i = 0; i < 8; ++i) { u32x2 w; w.x = cvt_pk_bf16(pv[i][0], pv[i][1]); w.y = cvt_pk_bf16(pv[i][2], pv[i][3]); *((u32x2*)(PB + (size_t)(m0 + i * NGW) * PLE) + lane) = w; } }
    }
}

__device__ __forceinline__ void s5_chunk_scan(const Args& a, LAS unsigned char* lds) {
    const int tid = threadIdx.x;
    const int wv = __builtin_amdgcn_readfirstlane(tid >> 6), n = tid & 63;
    unsigned char* ws = a.ws;
    LAS float* EX = (LAS float*)(lds + LDSCTL_OFF + 1024);
    for (int blk = blockIdx.x; blk < 256; blk += gridDim.x) {
        const int g = blk >> 2, b = blk & 3;
        float sr[32], si[32];
        float abr = 0.f, abi = 0.f;
        if (wv < 4) {
            abr = ((const float*)(ws + WS_AB64))[(g * 64 + n) * 2]; abi = ((const float*)(ws + WS_AB64))[(g * 64 + n) * 2 + 1];
            const float* S0 = (const float*)(ws + WS_S5S) + (size_t)(g * 512 + b * NCH + wv * 32) * 128;
            const float* S1 = (const float*)(ws + WS_S5S2) + (size_t)(g * 512 + b * NCH + wv * 32) * 128;
#pragma unroll
            for (int j = 0; j < 32; ++j) { sr[j] = S0[j * 128 + n] + S1[j * 128 + n]; si[j] = S0[j * 128 + 64 + n] + S1[j * 128 + 64 + n]; }
            float hr = 0.f, hi = 0.f;
#pragma unroll
            for (int j = 0; j < 32; ++j) { const float nr = abr * hr - abi * hi + sr[j], ni = abr * hi + abi * hr + si[j]; sr[j] = hr; si[j] = hi; hr = nr; hi = ni; }
            EX[wv * 128 + n] = hr; EX[wv * 128 + 64 + n] = hi;
        }
        __syncthreads();
        if (wv < 4) {
            float pr = abr, pi = abi;
#pragma unroll
            for (int q = 0; q < 5; ++q) { const float t = pr * pr - pi * pi; pi = 2.f * pr * pi; pr = t; }
            float cr = 0.f, ci = 0.f;
            for (int w2 = 0; w2 < wv; ++w2) { const float er = EX[w2 * 128 + n], ei = EX[w2 * 128 + 64 + n];
                const float nr = pr * cr - pi * ci + er, ni = pr * ci + pi * cr + ei; cr = nr; ci = ni; }
            bf16_t* AUp = (bf16_t*)(ws + WS_AU) + (size_t)(g * 512 + b * NCH + wv * 32) * AUW;
#pragma unroll
            for (int j = 0; j < 32; ++j) { AUp[(size_t)j * AUW + n] = f2bf(sr[j] + cr); AUp[(size_t)j * AUW + 64 + n] = f2bf(si[j] + ci);
                const float nr = abr * cr - abi * ci, ni = abr * ci + abi * cr; cr = nr; ci = ni; }
        }
        __syncthreads();
    }
}

namespace ssd {
constexpr int XT_OFF = 0, XT_STRIDE = 144;
constexpr int CM_OFF = 36864, NM_STRIDE = 272;
constexpr int BM_OFF = 54272;
constexpr int SH_OFF = 71680;
constexpr int DTS_OFF = 108544, CSS_OFF = 109568, RED_OFF = 110592;
constexpr int BMT_OFF = 36864;

__device__ __forceinline__ int tsw(int r, int ck) { return r * XT_STRIDE + ((ck ^ ((r >> 3) & 7)) << 4); }
constexpr int WGT_OFF = 112640;

struct Raw { u32x4 x[7]; u32x4 bc[7]; float dt; };

__device__ __forceinline__ void load_weights(const Args& a, LAS unsigned char* lds, int g) {
    LAS float* W = (LAS float*)(lds + WGT_OFF);
    int tt = threadIdx.x; asm volatile("" : "+v"(tt));
    for (int e = tt; e < 2560; e += NTHR) { const int k = e >> 9, chl = e & 511;
        const int ch = chl < 256 ? g * 256 + chl : (chl < 384 ? 1024 + g * 128 + (chl - 256) : 1536 + g * 128 + (chl - 384));
        W[e] = k < 4 ? a.in[I_CONVW][k * 2048 + ch] : a.in[I_CONVB][ch]; }
    if (tt < 256) W[2560 + tt] = a.in[I_SSDNW][g * 256 + tt];
}
template <bool OUTP, int PART = 0>
__device__ __forceinline__ void load_raw(const Args& a, int u, Raw& raw) {
    const int tid = threadIdx.x, b = u >> 9, c = (u >> 2) & 127, g = u & 3;
    const size_t t0 = (size_t)b * SEQ + (size_t)c * 64;
    const bf16_t* XBC = (const bf16_t*)(a.ws + WS_XBC);
    const int wv = tid >> 6, l0 = ((((tid >> 3) & 7) + 8 * (wv & 1)) * 4), chx = g * 256 + ((tid & 7) + 8 * (wv >> 1)) * 8;
    const int chb = 1024 + (OUTP ? (tid >> 8) * 512 : 0) + g * 128 + ((tid & 7) + 8 * ((wv >> 1) & 1)) * 8;
    const bf16_t* px = XBC + ((long)t0 + l0 - 3) * 2048 + chx; const bf16_t* pb = XBC + ((long)t0 + l0 - 3) * 2048 + chb;
#pragma unroll
    for (int r = 0; r < 7; ++r) {
        if (PART != 2) raw.x[r] = *(const u32x4*)(px + r * 2048);
        if (PART != 1) { u32x4 wb = (u32x4){0u, 0u, 0u, 0u};
            if (OUTP || tid >= 256) wb = *(const u32x4*)(pb + r * 2048);
            raw.bc[r] = wb; } }
    if (PART != 2) { raw.dt = 0.f;
        if (tid < 256) raw.dt = ((const float*)(a.ws + WS_DT))[(t0 + (tid & 63)) * 16 + g * 4 + (tid >> 6)]; }
}
__device__ __forceinline__ void conv_regs(const u32x4 (&rw)[7], const LAS float* W, int chl, bool zlo, float (&o)[4][8]) {
    f32x4 w0[4], w1[4];
#pragma unroll
    for (int k = 0; k < 4; ++k) { w0[k] = *(const LAS f32x4*)(W + k * 512 + chl); w1[k] = *(const LAS f32x4*)(W + k * 512 + chl + 4); }
    const f32x4 b0 = *(const LAS f32x4*)(W + 2048 + chl), b1 = *(const LAS f32x4*)(W + 2048 + chl + 4);
    f32x4 s0[4], s1[4];
#pragma unroll
    for (int dl = 0; dl < 4; ++dl) { s0[dl] = b0; s1[dl] = b1; }
#pragma unroll
    for (int r = 0; r < 7; ++r) { f32x4 x0, x1; pg8::unpack8(rw[r], x0, x1);
        if (r < 3 && zlo) { x0 = (f32x4){0.f, 0.f, 0.f, 0.f}; x1 = (f32x4){0.f, 0.f, 0.f, 0.f}; }
#pragma unroll
        for (int dl = 0; dl < 4; ++dl) { const int k = r - dl; if (k >= 0 && k < 4) { s0[dl] += w0[k] * x0; s1[dl] += w1[k] * x1; } } }
#pragma unroll
    for (int dl = 0; dl < 4; ++dl)
#pragma unroll
        for (int e = 0; e < 4; ++e) { o[dl][e] = siluf_(s0[dl][e]); o[dl][4 + e] = siluf_(s1[dl][e]); }
}
__device__ __forceinline__ void dt_cs(LAS unsigned char* lds, float dtv, float negA) {
    const int tid = threadIdx.x, lane = tid & 63, h = tid >> 6;
    if (tid < 256) {
        float v = dtv * negA;
#pragma unroll
        for (int d = 1; d < 64; d <<= 1) { const float t = __shfl_up(v, d); if (lane >= d) v += t; }
        ((LAS float*)(lds + DTS_OFF))[h * 64 + lane] = dtv; ((LAS float*)(lds + CSS_OFF))[h * 64 + lane] = v;
    }
}
typedef __bf16 bf16x2_t __attribute__((ext_vector_type(2)));
__device__ __forceinline__ unsigned cvt2(float lo, float hi) { const f32x2 v = {lo, hi}; const bf16x2_t r = __builtin_convertvector(v, bf16x2_t); return __builtin_bit_cast(unsigned, r); }
__device__ __forceinline__ u32x2 pk4(float a, float b, float c, float d) { u32x2 w; w.x = cvt2(a, b); w.y = cvt2(c, d); return w; }

__device__ __forceinline__ int step_unit(int bx, int G, int s) { const int su = bx + (s >> 2) * G, j = s & 3; return ((su >> 7) << 9) | ((((su >> 2) & 31) * 4 + j) << 2) | (su & 3); }

__device__ __forceinline__ void states_unit(const Args& a, LAS unsigned char* lds, int u, int un, int& gl, float& negA, Raw& cur, f32x4 (&acc)[2][8], float& dprod) {
    const int tid = threadIdx.x, lane = tid & 63, wave = __builtin_amdgcn_readfirstlane(tid >> 6), fr = lane & 15, fq = lane >> 4;
    const LAS float* DTS = (const LAS float*)(lds + DTS_OFF); const LAS float* CSS = (const LAS float*)(lds + CSS_OFF); const LAS float* W = (const LAS float*)(lds + WGT_OFF);
    const int b = u >> 9, c = (u >> 2) & 127, g = u & 3, j = c & 3;
    __syncthreads();
    if (g != gl) { load_weights(a, lds, g); gl = g; negA = -expf(a.in[I_ALOG][g * 4 + ((tid >> 6) & 3)]); }
    dt_cs(lds, cur.dt, negA);
    __syncthreads();
    {
        const int oct = (tid & 7) + 8 * (wave >> 1), run = ((tid >> 3) & 7) + 8 * (wave & 1), l0 = run * 4, hh = oct >> 3; float o[4][8];
        conv_regs(cur.x, W, oct * 8, c == 0 && run == 0, o);
        asm volatile("" ::: "memory");
        if (un >= 0) load_raw<false, 1>(a, un, cur);
        float sc[4]; const float ce = CSS[hh * 64 + 63];
#pragma unroll
        for (int dl = 0; dl < 4; ++dl) sc[dl] = DTS[hh * 64 + l0 + dl] * __expf(ce - CSS[hh * 64 + l0 + dl]);
#pragma unroll
        for (int jj = 0; jj < 8; ++jj) *(LAS u32x2*)(lds + XT_OFF + tsw(oct * 8 + jj, run >> 1) + (run & 1) * 8) = pk4(o[0][jj] * sc[0], o[1][jj] * sc[1], o[2][jj] * sc[2], o[3][jj] * sc[3]);
    }
    if (tid >= 256) {
        const int oct = (tid & 7) + 8 * ((wave >> 1) & 1), run = ((tid >> 3) & 7) + 8 * (wave & 1); float o[4][8];
        conv_regs(cur.bc, W, 256 + oct * 8, c == 0 && run == 0, o);
#pragma unroll
        for (int jj = 0; jj < 8; ++jj) *(LAS u32x2*)(lds + BMT_OFF + tsw(oct * 8 + jj, run >> 1) + (run & 1) * 8) = pk4(o[0][jj], o[1][jj], o[2][jj], o[3][jj]);
    }
    asm volatile("" ::: "memory");
    if (un >= 0) load_raw<false, 2>(a, un, cur);
    __syncthreads();
    const int h = wave >> 1, ph = wave & 1;
    const float dec = __expf(CSS[h * 64 + 63]);
    if (j == 0) { dprod = dec;
#pragma unroll
        for (int pi = 0; pi < 2; ++pi)
#pragma unroll
            for (int nj = 0; nj < 8; ++nj) acc[pi][nj] = (f32x4){0.f, 0.f, 0.f, 0.f};
    } else { dprod *= dec;
#pragma unroll
        for (int pi = 0; pi < 2; ++pi)
#pragma unroll
            for (int nj = 0; nj < 8; ++nj) acc[pi][nj] = acc[pi][nj] * dec; }
#pragma unroll
    for (int ks = 0; ks < 2; ++ks) { bf16x8 xf[2];
#pragma unroll
        for (int pi = 0; pi < 2; ++pi) xf[pi] = *(const LAS bf16x8*)(lds + XT_OFF + tsw(h * 64 + ph * 32 + pi * 16 + fr, ks * 4 + fq));
#pragma unroll
        for (int nj = 0; nj < 8; ++nj) { const bf16x8 bf = *(const LAS bf16x8*)(lds + BMT_OFF + tsw(nj * 16 + fr, ks * 4 + fq));
#pragma unroll
            for (int pi = 0; pi < 2; ++pi) acc[pi][nj] = __builtin_amdgcn_mfma_f32_16x16x32_bf16(bf, xf[pi], acc[pi][nj], 0, 0, 0); } }
    if (j == 3) {
        bf16_t* STp = (bf16_t*)a.out + ((size_t)(b * NSC + (c >> 2)) * 16 + g * 4 + h) * 8192;
#pragma unroll
        for (int pi = 0; pi < 2; ++pi)
#pragma unroll
            for (int nj = 0; nj < 8; ++nj) *(u32x2*)(STp + (ph * 32 + pi * 16 + fr) * 128 + nj * 16 + 4 * fq) = pk4(acc[pi][nj][0], acc[pi][nj][1], acc[pi][nj][2], acc[pi][nj][3]);
        if (ph == 0 && lane == 0) ((float*)(a.ws + WS_CD))[(b * NSC + (c >> 2)) * 16 + g * 4 + h] = dprod;
    }
}
__device__ __forceinline__ void states_phase(const Args& a, LAS unsigned char* lds, int bx, int G) {
    const int NSU = NB * NSC * 4;
    if (bx >= NSU) return;
    const int nsteps = 4 * ((NSU - bx + G - 1) / G);
    Raw ra; load_raw<false>(a, step_unit(bx, G, 0), ra);
    f32x4 acc[2][8]; float dprod = 1.f;
#pragma unroll
    for (int pi = 0; pi < 2; ++pi)
#pragma unroll
        for (int nj = 0; nj < 8; ++nj) acc[pi][nj] = (f32x4){0.f, 0.f, 0.f, 0.f};
    int gl = -1; float negA = 0.f;
    for (int s = 0; s < nsteps; ++s) states_unit(a, lds, step_unit(bx, G, s), (s + 1 < nsteps) ? step_unit(bx, G, s + 1) : -1, gl, negA, ra, acc, dprod);
}

__device__ __forceinline__ void state_scan(const Args& a) {
    const int tid = threadIdx.x;
    const float* CD = (const float*)(a.ws + WS_CD);
    for (int gt = blockIdx.x * NTHR + tid; gt < NB * 32768; gt += gridDim.x * NTHR) {
        const int b = gt >> 15, rem = gt & 32767, h = rem >> 11;
        bf16_t* base = (bf16_t*)a.out + (size_t)b * NSC * 131072 + (size_t)rem * 4;
        f32x4 st = (f32x4){0.f, 0.f, 0.f, 0.f};
        for (int c0 = 0; c0 < NSC; c0 += 16) {
            u32x2 lw[16]; float dc[16];
#pragma unroll
            for (int j = 0; j < 16; ++j) { lw[j] = *(const u32x2*)(base + (size_t)(c0 + j) * 131072); dc[j] = CD[(b * NSC + c0 + j) * 16 + h]; }
#pragma unroll
            for (int j = 0; j < 16; ++j) { *(u32x2*)(base + (size_t)(c0 + j) * 131072) = pk4(st[0], st[1], st[2], st[3]);
                const f32x4 lv = (f32x4){bflo(lw[j].x), bfhi(lw[j].x), bflo(lw[j].y), bfhi(lw[j].y)}; st = st * dc[j] + lv; }
        }
    }
}

constexpr int BMT2_OFF = 123904;

struct Late { bf16x8 pf[2][4]; u32x2 zw[4][2]; };
__device__ __forceinline__ bf16x8 cat8(const u32x2 lo, const u32x2 hi) { const u32x4 w = (u32x4){lo.x, lo.y, hi.x, hi.y}; return __builtin_bit_cast(bf16x8, w); }
__device__ __forceinline__ void load_state(const Args& a, int u, int h, int ph, int fr, int fq, Late& L) {
    const int b = u >> 9, c = (u >> 2) & 127, g = u & 3;
    const bf16_t* STp = (const bf16_t*)a.out + ((size_t)(b * NSC + (c >> 2)) * 16 + g * 4 + h) * 8192;
#pragma unroll
    for (int pt = 0; pt < 2; ++pt)
#pragma unroll
        for (int ks = 0; ks < 4; ++ks) { const bf16_t* p = STp + (ph * 32 + pt * 16 + fr) * 128 + ks * 32 + 4 * fq;
            L.pf[pt][ks] = cat8(*(const u32x2*)p, *(const u32x2*)(p + 16)); }
}
__device__ __forceinline__ void load_z(const Args& a, int u, int h, int ph, int fr, int fq, Late& L) {
    const int b = u >> 9, c = (u >> 2) & 127, g = u & 3;
    const size_t t0 = (size_t)b * SEQ + (size_t)c * 64;
    const bf16_t* ZZ = (const bf16_t*)(a.ws + WS_ZZ);
#pragma unroll
    for (int mi = 0; mi < 4; ++mi)
#pragma unroll
        for (int nj = 0; nj < 2; ++nj) L.zw[mi][nj] = *(const u32x2*)(ZZ + (t0 + mi * 16 + fr) * 2048 + 1024 + g * 256 + h * 64 + ph * 32 + nj * 16 + 4 * fq);
}
__device__ __forceinline__ void out_unit(const Args& a, LAS unsigned char* lds, int u, int un, int& gl, float& negA, Raw& cur, Late& L) {
    const int tid = threadIdx.x, lane = tid & 63, wave = __builtin_amdgcn_readfirstlane(tid >> 6), fr = lane & 15, fq = lane >> 4;
    bf16_t* ZZ = (bf16_t*)(a.ws + WS_ZZ);
    const LAS float* DTS = (const LAS float*)(lds + DTS_OFF); const LAS float* CSS = (const LAS float*)(lds + CSS_OFF); LAS float* RED = (LAS float*)(lds + RED_OFF);
    const LAS float* W = (const LAS float*)(lds + WGT_OFF);
    const int h = wave >> 1, ph = wave & 1;
    const int b = u >> 9, c = (u >> 2) & 127, g = u & 3, j = c & 3;
    const size_t t0 = (size_t)b * SEQ + (size_t)c * 64;
    __syncthreads();
    if (j == 0) load_state(a, u, h, ph, fr, fq, L);
    if (g != gl) { load_weights(a, lds, g); gl = g; negA = -expf(a.in[I_ALOG][g * 4 + ((tid >> 6) & 3)]); __syncthreads(); }
    dt_cs(lds, cur.dt, negA);
    {
        const int oct = (tid & 7) + 8 * (wave >> 1), run = ((tid >> 3) & 7) + 8 * (wave & 1); float o[4][8];
        conv_regs(cur.x, W, oct * 8, c == 0 && run == 0, o);
        asm volatile("" ::: "memory");
        if (un >= 0) load_raw<true, 1>(a, un, cur);
#pragma unroll
        for (int jj = 0; jj < 8; ++jj) *(LAS u32x2*)(lds + XT_OFF + tsw(oct * 8 + jj, run >> 1) + (run & 1) * 8) = pk4(o[0][jj], o[1][jj], o[2][jj], o[3][jj]);
    }
    {
        const int sel = tid >> 8, oct = (tid & 7) + 8 * ((wave >> 1) & 1), run = ((tid >> 3) & 7) + 8 * (wave & 1), l0 = run * 4; float o[4][8];
        conv_regs(cur.bc, W, 256 + sel * 128 + oct * 8, c == 0 && run == 0, o);
        const int off = sel ? CM_OFF : BM_OFF;
#pragma unroll
        for (int dl = 0; dl < 4; ++dl) { u32x4 w; w.x = cvt2(o[dl][0], o[dl][1]); w.y = cvt2(o[dl][2], o[dl][3]); w.z = cvt2(o[dl][4], o[dl][5]); w.w = cvt2(o[dl][6], o[dl][7]);
            *(LAS u32x4*)(lds + off + (l0 + dl) * NM_STRIDE + oct * 16) = w; }
        if (sel == 0 && j < 3) {
#pragma unroll
            for (int jj = 0; jj < 8; ++jj) *(LAS u32x2*)(lds + BMT2_OFF + tsw(oct * 8 + jj, run >> 1) + (run & 1) * 8) = pk4(o[0][jj], o[1][jj], o[2][jj], o[3][jj]); }
    }
    asm volatile("" ::: "memory");
    if (un >= 0) load_raw<true, 2>(a, un, cur);
    load_z(a, u, h, ph, fr, fq, L);
    __syncthreads();
    {
        const int mi = wave >> 1, nj0 = (wave & 1) * 2;
        f32x4 accG[2] = {(f32x4){0.f, 0.f, 0.f, 0.f}, (f32x4){0.f, 0.f, 0.f, 0.f}};
#pragma unroll
        for (int ks = 0; ks < 4; ++ks) { const bf16x8 cf = *(const LAS bf16x8*)(lds + CM_OFF + (mi * 16 + fr) * NM_STRIDE + (ks * 32 + fq * 8) * 2);
#pragma unroll
            for (int jj = 0; jj < 2; ++jj) { const bf16x8 bf = *(const LAS bf16x8*)(lds + BM_OFF + ((nj0 + jj) * 16 + fr) * NM_STRIDE + (ks * 32 + fq * 8) * 2);
                accG[jj] = __builtin_amdgcn_mfma_f32_16x16x32_bf16(bf, cf, accG[jj], 0, 0, 0); } }
        const int l = mi * 16 + fr;
#pragma unroll
        for (int hh = 0; hh < 4; ++hh) { const float csl = CSS[hh * 64 + l];
#pragma unroll
            for (int jj = 0; jj < 2; ++jj) { const int s0 = (nj0 + jj) * 16 + 4 * fq;
                const f32x4 css = *(const LAS f32x4*)(CSS + hh * 64 + s0), dts = *(const LAS f32x4*)(DTS + hh * 64 + s0); float v[4];
#pragma unroll
                for (int e = 0; e < 4; ++e) v[e] = (s0 + e <= l) ? accG[jj][e] * __expf(csl - css[e]) * dts[e] : 0.f;
                *(LAS u32x2*)(lds + SH_OFF + hh * 9216 + l * XT_STRIDE + s0 * 2) = pk4(v[0], v[1], v[2], v[3]); } }
    }
    __syncthreads();
    const float Dh = a.in[I_SSDD][g * 4 + h];
    f32x4 gv[4][2];
#pragma unroll
    for (int half = 0; half < 2; ++half) {
        f32x4 accD[2][2], accO[2][2];
#pragma unroll
        for (int mm = 0; mm < 2; ++mm)
#pragma unroll
            for (int nj = 0; nj < 2; ++nj) { accD[mm][nj] = (f32x4){0.f, 0.f, 0.f, 0.f}; accO[mm][nj] = (f32x4){0.f, 0.f, 0.f, 0.f}; }
#pragma unroll
        for (int ks = 0; ks < 2; ++ks) { bf16x8 xf[2];
#pragma unroll
            for (int nj = 0; nj < 2; ++nj) xf[nj] = *(const LAS bf16x8*)(lds + XT_OFF + tsw(h * 64 + ph * 32 + nj * 16 + fr, ks * 4 + fq));
#pragma unroll
            for (int mm = 0; mm < 2; ++mm) { const bf16x8 sf = *(const LAS bf16x8*)(lds + SH_OFF + h * 9216 + ((half * 2 + mm) * 16 + fr) * XT_STRIDE + (ks * 32 + fq * 8) * 2);
#pragma unroll
                for (int nj = 0; nj < 2; ++nj) accD[mm][nj] = __builtin_amdgcn_mfma_f32_16x16x32_bf16(xf[nj], sf, accD[mm][nj], 0, 0, 0); } }
#pragma unroll
        for (int ks = 0; ks < 4; ++ks)
#pragma unroll
            for (int mm = 0; mm < 2; ++mm) { const LAS unsigned char* cp = lds + CM_OFF + ((half * 2 + mm) * 16 + fr) * NM_STRIDE + (ks * 32 + 4 * fq) * 2;
                const bf16x8 cf = cat8(*(const LAS u32x2*)cp, *(const LAS u32x2*)(cp + 32));
#pragma unroll
                for (int nj = 0; nj < 2; ++nj) accO[mm][nj] = __builtin_amdgcn_mfma_f32_16x16x32_bf16(L.pf[nj][ks], cf, accO[mm][nj], 0, 0, 0); }
#pragma unroll
        for (int mm = 0; mm < 2; ++mm) { const int mi = half * 2 + mm, l = mi * 16 + fr; const float el = __expf(CSS[h * 64 + l]); float ss = 0.f;
#pragma unroll
            for (int nj = 0; nj < 2; ++nj) { const int p0 = ph * 32 + nj * 16 + 4 * fq;
                const f32x4 z = (f32x4){bflo(L.zw[mi][nj].x), bfhi(L.zw[mi][nj].x), bflo(L.zw[mi][nj].y), bfhi(L.zw[mi][nj].y)};
#pragma unroll
                for (int e = 0; e < 4; ++e) { const float xv = bf2f(*(const LAS unsigned short*)(lds + XT_OFF + tsw(h * 64 + p0 + e, l >> 3) + (l & 7) * 2));
                    const float y = accD[mm][nj][e] + el * accO[mm][nj][e] + Dh * xv; const float gg = y * siluf_(z[e]); gv[mi][nj][e] = gg; ss += gg * gg; } }
            ss += __shfl_xor(ss, 16); ss += __shfl_xor(ss, 32);
            if (fq == 0) RED[wave * 64 + l] = ss; }
        asm volatile("" ::: "memory");
    }
    __syncthreads();
#pragma unroll
    for (int mi = 0; mi < 4; ++mi) { const int l = mi * 16 + fr; float tot = 0.f;
#pragma unroll
        for (int w = 0; w < 8; ++w) tot += RED[w * 64 + l];
        const float r = rsqrtf(tot * (1.f / 256.f) + EPS);
#pragma unroll
        for (int nj = 0; nj < 2; ++nj) { const int p0 = ph * 32 + nj * 16 + 4 * fq; const f32x4 nw = *(const LAS f32x4*)(W + 2560 + h * 64 + p0);
            *(u32x2*)(ZZ + (t0 + l) * 2048 + 1024 + g * 256 + h * 64 + p0) = pk4(gv[mi][nj][0] * r * nw[0], gv[mi][nj][1] * r * nw[1], gv[mi][nj][2] * r * nw[2], gv[mi][nj][3] * r * nw[3]); } }
    if (j < 3) {
        const float ce = CSS[h * 64 + 63], dec = __expf(ce);
#pragma unroll
        for (int pt = 0; pt < 2; ++pt) {
            f32x4 as[8];
#pragma unroll
            for (int ks = 0; ks < 4; ++ks) { const u32x4 w = __builtin_bit_cast(u32x4, L.pf[pt][ks]);
                as[2 * ks] = (f32x4){bflo(w.x), bfhi(w.x), bflo(w.y), bfhi(w.y)} * dec; as[2 * ks + 1] = (f32x4){bflo(w.z), bfhi(w.z), bflo(w.w), bfhi(w.w)} * dec; }
#pragma unroll
            for (int k2 = 0; k2 < 2; ++k2) {
                const u32x4 xw = *(const LAS u32x4*)(lds + XT_OFF + tsw(h * 64 + ph * 32 + pt * 16 + fr, k2 * 4 + fq));
                const int lb = h * 64 + k2 * 32 + fq * 8;
                const f32x4 d0 = *(const LAS f32x4*)(DTS + lb), d1 = *(const LAS f32x4*)(DTS + lb + 4), c0 = *(const LAS f32x4*)(CSS + lb), c1 = *(const LAS f32x4*)(CSS + lb + 4);
                f32x4 x0, x1; pg8::unpack8(xw, x0, x1);
#pragma unroll
                for (int e = 0; e < 4; ++e) { x0[e] *= d0[e] * __expf(ce - c0[e]); x1[e] *= d1[e] * __expf(ce - c1[e]); }
                const u32x4 xs = (u32x4){cvt2(x0[0], x0[1]), cvt2(x0[2], x0[3]), cvt2(x1[0], x1[1]), cvt2(x1[2], x1[3])};
                const bf16x8 xf = __builtin_bit_cast(bf16x8, xs);
#pragma unroll
                for (int nt = 0; nt < 8; ++nt) { const bf16x8 bf = *(const LAS bf16x8*)(lds + BMT2_OFF + tsw(nt * 16 + fr, k2 * 4 + fq));
                    as[nt] = __builtin_amdgcn_mfma_f32_16x16x32_bf16(bf, xf, as[nt], 0, 0, 0); } }
#pragma unroll
            for (int ks = 0; ks < 4; ++ks) { const u32x4 w = (u32x4){cvt2(as[2 * ks][0], as[2 * ks][1]), cvt2(as[2 * ks][2], as[2 * ks][3]), cvt2(as[2 * ks + 1][0], as[2 * ks + 1][1]), cvt2(as[2 * ks + 1][2], as[2 * ks + 1][3])};
                L.pf[pt][ks] = __builtin_bit_cast(bf16x8, w); }
        }
    }
}
__device__ __forceinline__ void out_phase(const Args& a, LAS unsigned char* lds, int bx, int G) {
    const int NSU = NB * NSC * 4;
    if (bx >= NSU) return;
    const int nsteps = 4 * ((NSU - bx + G - 1) / G);
    Raw ra; Late L;
    load_raw<true>(a, step_unit(bx, G, 0), ra);
#pragma unroll
    for (int pt = 0; pt < 2; ++pt)
#pragma unroll
        for (int ks = 0; ks < 4; ++ks) L.pf[pt][ks] = (bf16x8){0, 0, 0, 0, 0, 0, 0, 0};
    int gl = -1; float negA = 0.f;
    for (int s = 0; s < nsteps; ++s) out_unit(a, lds, step_unit(bx, G, s), (s + 1 < nsteps) ? step_unit(bx, G, s + 1) : -1, gl, negA, ra, L);
}
}

__device__ __forceinline__ void final_norm(const Args& a, int vcu, int G) {
    const int tid = threadIdx.x, lane = tid & 63, wave = tid >> 6;
    const float* SS2 = (const float*)(a.ws + WS_SS2);
    const int gw = vcu * NWAVES + wave, NGW = G * NWAVES;
    f32x4 wv[4];
#pragma unroll
    for (int j = 0; j < 4; ++j) wv[j] = *((const f32x4*)a.in[I_FINALW] + lane + 64 * j);
    for (int m = gw; m < M; m += NGW) {
        const f32x4 s0 = *(const f32x4*)(SS2 + (size_t)m * 16), s1 = *(const f32x4*)(SS2 + (size_t)m * 16 + 4), s2 = *(const f32x4*)(SS2 + (size_t)m * 16 + 8), s3 = *(const f32x4*)(SS2 + (size_t)m * 16 + 12);
        const f32x4 st = (s0 + s1) + (s2 + s3);
        const float r = rsqrtf(((st[0] + st[1]) + (st[2] + st[3])) * (1.f / 1024.f) + EPS);
        f32x4* o = (f32x4*)(a.out + (size_t)m * DM) + lane;
#pragma unroll
        for (int j = 0; j < 4; ++j) { const f32x4 h = o[64 * j]; o[64 * j] = h * r * wv[j]; }
    }
}

__global__ void __launch_bounds__(NTHR, 2) mega_fwd(Args args) {
    extern __shared__ __attribute__((aligned(16))) unsigned char lds_raw[];
    LAS unsigned char* lds = (LAS unsigned char*)lds_raw;
    const int tid = threadIdx.x;
    const int G = gridDim.x; const int bx = blockIdx.x; const int vcu = (G % 8 == 0) ? (bx % 8) * (G / 8) + bx / 8 : bx;
    unsigned char* ws = args.ws;
    unsigned* ctl = (unsigned*)(ws + WS_CTL);
    for (int u = tid; u < (LDS_BYTES - LDSCTL_OFF) / 4; u += NTHR) ((LAS unsigned*)(lds + LDSCTL_OFF))[u] = 0u;
    __syncthreads();
    XcdBarrier bar; bar.bar = ctl + 4096; bar.x = 0; bar.st = nullptr;
    if (MK_N_LAUNCHES == 1) bar = xcd_barrier_post(ctl + 4096, (volatile LAS unsigned*)(lds + LDSCTL_OFF + 64));
    const int lo = args.ph_lo, hi = args.ph_hi;
#define IN(k) (lo <= (k) && (k) < hi)
#define SEAM(k) do { if (IN(k) && IN((k) + 1)) xcd_barrier(bar); } while (0)

    if (IN(0)) { for (int rep = 0; rep < (DBL_PHASE == 0 ? 2 : 1); ++rep) { p0_prologue(args, lds, vcu, G); if (DBL_PHASE == 0 && rep == 0) xcd_barrier(bar); } } SEAM(0);
    if (IN(1)) for (int rep = 0; rep < (DBL_PHASE == 1 ? 2 : 1); ++rep) {
        if (rep) xcd_barrier(bar);
        pg8::PlainOrder S; S.init(M, 5120, G, bx, ws + WS_XN, 2048, ws + WS_WIN, 2048, 16);
        pg8::EpiInProj E{(bf16_t*)(ws + WS_AU), (bf16_t*)(ws + WS_ZZ), (bf16_t*)(ws + WS_XBC)};
        pg8::gemm_phase<pg8::EpiInProj, pg8::PlainOrder, true, false>(lds, S, E, 2048, 2048);
    } SEAM(1);
    if (IN(2)) for (int rep = 0; rep < (DBL_PHASE == 2 ? 2 : 1); ++rep) {
        if (rep) xcd_barrier(bar);
        pg8::S5SOrder S{bx, (const char*)(ws + WS_AU), (const char*)(ws + WS_P)};
        pg8::EpiS5S E{(float*)(ws + WS_S5S), (long)((WS_S5S2 - WS_S5S) / 4)};
        pg8::gemm_phase<pg8::EpiS5S, pg8::S5SOrder, false, false>(lds, S, E, AUW * 2, 2048);
        if (__builtin_amdgcn_readfirstlane(tid) >= 256) __builtin_amdgcn_s_setprio(1);
        ssd::states_phase(args, lds, bx, G);
        __builtin_amdgcn_s_setprio(0);
    } SEAM(2);
    if (IN(3)) { s5_chunk_scan(args, lds); ssd::state_scan(args); } SEAM(3);
    if (IN(4)) {
        pg8::S5YOrder S{bx, (const char*)(ws + WS_AU), (const char*)(ws + WS_Q), (const char*)(ws + WS_KR)};
        pg8::EpiS5Y E{(bf16_t*)((unsigned char*)args.out + YPRE_OFF)};
        pg8::gemm_phase<pg8::EpiS5Y, pg8::S5YOrder, true, true>(lds, S, E, AUW * 2, 256);
        if (__builtin_amdgcn_readfirstlane(tid) >= 256) __builtin_amdgcn_s_setprio(1);
        ssd::out_phase(args, lds, bx, G);
        __builtin_amdgcn_s_setprio(0);
    } SEAM(4);
    if (IN(5)) {
#define P5_GLU() do { pg8::PlainOrder S; S.init(M, 1024, G, bx, (unsigned char*)args.out + YPRE_OFF, 2048, ws + WS_WGLU, 2048, 16); \
            pg8::EpiGlu E{(const bf16_t*)((unsigned char*)args.out + YPRE_OFF), (bf16_t*)(ws + WS_ZZ), args.in[I_BGLU]}; \
            pg8::gemm_phase<pg8::EpiGlu, pg8::PlainOrder, true, false>(lds, S, E, 2048, 2048); } while (0)
#define P5_PLE() do { pg8::PlainOrder S; S.init(M, 1024, G, bx, ws + WS_PB, 512, ws + WS_WPLE, 512, 4); \
            pg8::EpiBf16 E{(bf16_t*)(ws + WS_XBC), 1024}; \
            pg8::gemm_phase<pg8::EpiBf16, pg8::PlainOrder, true, false>(lds, S, E, 512, 512); } while (0)
        if (bx & 1) { P5_PLE(); P5_GLU(); } else { P5_GLU(); P5_PLE(); }
#undef P5_GLU
#undef P5_PLE
    } SEAM(5);
    if (IN(6)) for (int rep = 0; rep < (DBL_PHASE == 6 ? 2 : 1); ++rep) {
        if (rep) xcd_barrier(bar);
        pg8::PlainOrder S; S.init(M, 1024, G, bx, ws + WS_ZZ, 4096, ws + WS_WOUT, 4096, 32);
        pg8::EpiOut E{(const bf16_t*)(ws + WS_XN), (const float*)(ws + WS_RINV), (bf16_t*)(ws + WS_AU), (float*)(ws + WS_SS1)};
        pg8::gemm_phase<pg8::EpiOut, pg8::PlainOrder, true, false>(lds, S, E, 4096, 4096);
    } SEAM(6);
    if (IN(7)) {
        pg8::PlainOrder S; S.init(M, 1024, G, bx, ws + WS_AU, 2048, ws + WS_WGATE, 2048, 16);
        pg8::EpiGateFinal E{args.out, (const bf16_t*)(ws + WS_AU), (const bf16_t*)(ws + WS_XBC), (const float*)(ws + WS_SS1), (float*)(ws + WS_SS2), ctl + 16384, args.in[I_FINALW], lds + LDSCTL_OFF};
        pg8::gemm_phase<pg8::EpiGateFinal, pg8::PlainOrder, true, false>(lds, S, E, 2048, 2048);
    }
#undef IN
#undef SEAM
}

extern "C" void kernel_launch(void* const* d_in, const int* in_sizes, int n_in, void* d_out, int out_size, void* d_ws, size_t ws_size, hipStream_t stream) {
    static int grid = 0;
    if (grid == 0) {
        if (n_in != 25 || out_size != M * DM || ws_size < WS_END) { fprintf(stderr, "kernel_launch: unexpected shapes (n_in %d, out %d, ws %zu)\n", n_in, out_size, ws_size); grid = -1; return; }
        int dev = 0, cus = 0, per_cu = 0;
        if (hipGetDevice(&dev) != hipSuccess || hipDeviceGetAttribute(&cus, hipDeviceAttributeMultiprocessorCount, dev) != hipSuccess) { grid = -1; return; }
        if (hipFuncSetAttribute((const void*)mega_fwd, hipFuncAttributeMaxDynamicSharedMemorySize, LDS_BYTES) != hipSuccess) { fprintf(stderr, "hipFuncSetAttribute failed\n"); grid = -1; return; }
        if (hipOccupancyMaxActiveBlocksPerMultiprocessor(&per_cu, (const void*)mega_fwd, NTHR, LDS_BYTES) != hipSuccess || per_cu < 1) { fprintf(stderr, "occupancy query: %d\n", per_cu); per_cu = 1; }
        (void)hipGetLastError();
        grid = cus;
    }
    if (grid < 0) return;
    (void)hipMemsetAsync((char*)d_ws + WS_CTL, 0, CTL_ZERO_BYTES, stream);
    Args a{};
    for (int i = 0; i < 25; ++i) a.in[i] = (const float*)d_in[i];
    a.out = (float*)d_out; a.ws = (unsigned char*)d_ws;
#if MK_N_LAUNCHES == 1
    a.ph_lo = 0; a.ph_hi = N_PHASES;
    void* kargs[] = {&a};
    hipError_t e = hipLaunchCooperativeKernel((const void*)mega_fwd, dim3(grid), dim3(NTHR), kargs, LDS_BYTES, stream);
    if (e != hipSuccess) fprintf(stderr, "cooperative launch failed: %s\n", hipGetErrorString(e));
#else
    for (int ph = 0; ph < N_PHASES; ++ph) { a.ph_lo = ph; a.ph_hi = ph + 1; hipLaunchKernelGGL(mega_fwd, dim3(grid), dim3(NTHR), LDS_BYTES, stream, a); }
#endif
}
```

```cpp
#include <hip/hip_runtime.h>
#include <cstdio>
#include <cstdint>

#ifndef MK_N_LAUNCHES
#define MK_N_LAUNCHES 1
#endif

#define LAS __attribute__((address_space(3)))
#define GAS __attribute__((address_space(1)))
typedef unsigned short bf16_t;
typedef short bf16x8 __attribute__((ext_vector_type(8)));
typedef float f32x4 __attribute__((ext_vector_type(4)));
typedef float f32x2 __attribute__((ext_vector_type(2)));
typedef unsigned u32x4 __attribute__((ext_vector_type(4)));
typedef unsigned u32x2 __attribute__((ext_vector_type(2)));

constexpr int NB = 4, SEQ = 8192, DM = 1024, M = NB * SEQ, NPROJ = 5136, PLE = 256;
constexpr int NCH = SEQ / 64;
constexpr int NSC = SEQ / 256;
constexpr size_t YPRE_OFF = 40 * (1u << 20);
constexpr int AUW = 1152;
constexpr float EPS = 1e-6f;
constexpr int NWAVES = 8, NTHR = 512;

constexpr size_t MiB = 1u << 20;
constexpr size_t WS_CTL   = 0;
constexpr size_t CTL_ZERO_BYTES = 1 * MiB;
constexpr size_t WS_WIN   = 1 * MiB;
constexpr size_t WS_WGLU  = 11 * MiB;
constexpr size_t WS_WOUT  = 13 * MiB;
constexpr size_t WS_WGATE = 17 * MiB;
constexpr size_t WS_WPLE  = 19 * MiB;
constexpr size_t WS_AB64  = 19 * MiB + 512 * 1024;
constexpr size_t WS_CD    = 19 * MiB + 576 * 1024;
constexpr size_t WS_SS1   = 20 * MiB;
constexpr size_t WS_SS2   = 22 * MiB;
constexpr size_t WS_RINV  = 23 * MiB;
constexpr size_t WS_DT    = 24 * MiB;
constexpr size_t WS_KR    = 26 * MiB;
constexpr size_t WS_Q     = 30 * MiB;
constexpr size_t WS_P     = 46 * MiB;
constexpr size_t WS_PB    = 62 * MiB;
constexpr size_t WS_S5S   = 78 * MiB;
constexpr size_t WS_XN    = 94 * MiB;
constexpr size_t WS_AU    = 158 * MiB;
constexpr size_t WS_ZZ    = 230 * MiB;
constexpr size_t WS_XBC   = 358 * MiB;
constexpr size_t WS_S5S2  = 486 * MiB;
constexpr size_t WS_END   = 502 * MiB;

constexpr int RING_BYTES = 131072, LDS_BYTES = 163840, LDSCTL_OFF = LDS_BYTES - 8192;

__device__ __forceinline__ float bf2f(unsigned short b) { return __uint_as_float((unsigned)b << 16); }
__device__ __forceinline__ float bflo(unsigned w) { return __uint_as_float(w << 16); }
__device__ __forceinline__ float bfhi(unsigned w) { return __uint_as_float(w & 0xffff0000u); }
__device__ __forceinline__ unsigned cvt_pk_bf16(float lo, float hi) { unsigned r; asm volatile("v_cvt_pk_bf16_f32 %0, %1, %2" : "=v"(r) : "v"(lo), "v"(hi)); return r; }
__device__ __forceinline__ unsigned short f2bf(float f) { return (unsigned short)(cvt_pk_bf16(f, 0.f) & 0xffffu); }
__device__ __forceinline__ float sigmoidf_(float x) { return __builtin_amdgcn_rcpf(1.f + __expf(-x)); }
__device__ __forceinline__ float siluf_(float x) { return x * sigmoidf_(x); }
__device__ __forceinline__ float gelu_tanh(float x) { const float u = 0.7978845608028654f * (x + 0.044715f * x * x * x); const float e = __expf(2.f * u); return x * (1.f - __builtin_amdgcn_rcpf(e + 1.f)); }
__device__ __forceinline__ float softplusf_(float x) { return x > 20.f ? x : log1pf(expf(x)); }
__device__ __forceinline__ float wave_sum(float v) {
#pragma unroll
    for (int o = 1; o < 64; o <<= 1) v += __shfl_xor(v, o);
    return v;
}

#define XB_TMO      128
#define XB_XCNT(j)  (256  + 64 * (j))
#define XB_XSUB(j)  (1280 + 64 * (j))
#define XB_XGEN(j)  (2304 + 64 * (j))
#define XB_TOP      3328
#define XB_TOPGEN   3392
#define XCD_BAR_WORDS 3456
#define XB_SPIN_CAP (1u << 18)
__device__ __forceinline__ unsigned xb_ld(unsigned* p)              { return __hip_atomic_load(p, __ATOMIC_RELAXED, __HIP_MEMORY_SCOPE_AGENT); }
__device__ __forceinline__ unsigned xb_add(unsigned* p, unsigned v) { return __hip_atomic_fetch_add(p, v, __ATOMIC_RELAXED, __HIP_MEMORY_SCOPE_AGENT); }
__device__ __forceinline__ unsigned xb_xcc_id() { return (unsigned)__builtin_amdgcn_s_getreg((3 << 11) | 20) & 0xFu; }
#define XB_SPIN(cond, bar) do { unsigned _sp = 0; while (cond) { __builtin_amdgcn_s_sleep(1); \
    if ((++_sp & 255u) == 0u) { if (xb_ld(&(bar)[XB_TMO])) break; if (_sp > XB_SPIN_CAP) { atomicAdd(&(bar)[XB_TMO], 1u); break; } } } } while (0)
struct XcdBarrier { unsigned* bar; unsigned x; volatile LAS unsigned* st; };
__device__ __forceinline__ XcdBarrier xcd_barrier_post(unsigned* bar, volatile LAS unsigned* st) {
    XcdBarrier b; b.bar = bar; b.x = xb_xcc_id(); b.st = st;
    if (threadIdx.x == 0) (void)xb_add(&bar[XB_XCNT(b.x)], 1u);
    return b;
}
__device__ __forceinline__ void xcd_barrier_complete(unsigned* bar, unsigned x, unsigned& nloc, unsigned& nx) {
    const unsigned G = gridDim.x * gridDim.y * gridDim.z;
    unsigned sum, cnt, mine, sp = 0u;
    for (;;) {
        sum = 0u; cnt = 0u; mine = 0u;
#pragma unroll
        for (unsigned j = 0; j < 16; ++j) { const unsigned c = xb_ld(&bar[XB_XCNT(j)]); sum += c; cnt += (c > 0u) ? 1u : 0u; mine = (j == x) ? c : mine; }
        if (sum == G) break;
        __builtin_amdgcn_s_sleep(1);
        if ((++sp & 255u) == 0u) { if (xb_ld(&bar[XB_TMO])) break; if (sp > XB_SPIN_CAP) { atomicAdd(&bar[XB_TMO], 1u); break; } }
    }
    nloc = mine > 0u ? mine : 1u; nx = cnt > 0u ? cnt : 1u;
}
__device__ __forceinline__ void xcd_barrier(const XcdBarrier& b) {
    asm volatile("s_waitcnt vmcnt(0)" ::: "memory");
    __syncthreads();
    if (threadIdx.x == 0) {
        unsigned* bar = b.bar;
        __builtin_amdgcn_s_waitcnt(0);
        unsigned nloc = b.st[0], nx = b.st[1];
        if (nloc == 0u) { xcd_barrier_complete(bar, b.x, nloc, nx); b.st[0] = nloc; b.st[1] = nx; }
        const unsigned old = xb_add(&bar[XB_XSUB(b.x)], 1u);
        const unsigned gen = old / nloc;
        if (old + 1u == (gen + 1u) * nloc) {
            __builtin_amdgcn_fence(__ATOMIC_RELEASE, "agent");
            asm volatile("s_waitcnt vmcnt(0)" ::: "memory");
            const unsigned og = xb_add(&bar[XB_TOP], 1u);
            const unsigned tg = og / nx;
            if (og + 1u == (tg + 1u) * nx) xb_add(&bar[XB_TOPGEN], 1u);
            else XB_SPIN(xb_ld(&bar[XB_TOPGEN]) == tg, bar);
            __builtin_amdgcn_fence(__ATOMIC_ACQUIRE, "agent");
            xb_add(&bar[XB_XGEN(b.x)], 1u);
            asm volatile("s_waitcnt vmcnt(0)" ::: "memory");
        } else {
            XB_SPIN(xb_ld(&bar[XB_XGEN(b.x)]) == gen, bar);
            __builtin_amdgcn_fence(__ATOMIC_ACQUIRE, "agent");
            asm volatile("s_waitcnt vmcnt(0)" ::: "memory");
        }
    }
    __syncthreads();
}

namespace pg8 {
constexpr int BM = 256, BK = 64, HALF = 128, HTB = HALF * BK * 2, NXCD = 8, WGM = 8;
__host__ __device__ __forceinline__ int lds_byte(int r, int c) { const int st = (r >> 4) * 2 + (c >> 5), rr = r & 15, cc = c & 31, ob = rr * 64 + cc * 2; return st * 1024 + (ob ^ (((ob >> 9) & 1) << 5)); }
__host__ __device__ __forceinline__ void stage_rc(int b, int& R, int& C) { const int st = b / 1024, sb = b % 1024, swz = sb ^ (((sb >> 9) & 1) << 5); R = (st >> 1) * 16 + swz / 64; C = (st & 1) * 32 + (swz % 64) / 2; }
__host__ __device__ __forceinline__ int perm32(int rho) { const int n = rho >> 4, i = rho & 15; return 8 * (i >> 2) + 4 * n + (i & 3); }

struct Unit { int pm, pn, g, nt; const char* a; const char* b; const char* bt; };

struct PlainOrder {
    int nM, nN, nwg, G, c, nt; const char* A; const char* B; long tsA, tsB;
    __device__ void init(int M_, int N_, int G_, int c_, const void* A_, long lda_b, const void* B_, long ldb_b, int nt_) {
        nM = M_ / BM; nN = N_ / BM; nwg = nM * nN; G = G_; c = c_; nt = nt_; A = (const char*)A_; B = (const char*)B_; tsA = 256 * lda_b; tsB = 256 * ldb_b; }
    __device__ bool next(int i, Unit& u) const {
        const long Lx = (long)i * G + c; if (Lx >= nwg) return false;
        int wgid = (int)Lx; { const int q = nwg / NXCD, r = nwg % NXCD, xcd = wgid % NXCD, off = wgid / NXCD; wgid = (xcd < r ? xcd * (q + 1) : r * (q + 1) + (xcd - r) * q) + off; }
        const int nig = WGM * nN, gid = wgid / nig, fm = gid * WGM, gsz = (nM - fm) < WGM ? (nM - fm) : WGM;
        u.pm = fm + ((wgid % nig) % gsz); u.pn = (wgid % nig) / gsz; u.g = 0; u.nt = nt;
        u.a = A + (long)u.pm * tsA; u.b = B + (long)u.pn * tsB; u.bt = u.b; return true;
    }
};

template <class Epi, class Sched, bool ALIGN_EPI, bool TOEP>
__device__ __forceinline__ void gemm_phase(LAS unsigned char* lds, const Sched& S, const Epi& E, const int lda_b, const int ldb_b) {
    const int tid = threadIdx.x, wid = __builtin_amdgcn_readfirstlane(tid >> 6), lane = tid & 63, wr = wid >> 2, wc = wid & 3, fr = lane & 15, fq = lane >> 4;
    unsigned voffA[2], voffB[2], voffT[2];
#pragma unroll
    for (int i = 0; i < 2; ++i) { int R, C; stage_rc(tid * 16 + i * 8192, R, C); const int Rb = Epi::PERM ? ((R & ~31) + perm32(R & 31)) : R;
        voffA[i] = (unsigned)(R * lda_b + C * 2); voffB[i] = (unsigned)(Rb * ldb_b + C * 2);
        voffT[i] = (unsigned)(((Rb & 15) * 2048 + (7 - (Rb >> 4)) * 16 + C) * 2); }
    const long kstep = BK * 2;
    const long hsA = (long)HALF * lda_b, hsBq = (long)HALF * ldb_b, hsBt = -256;
    const unsigned ldsw = (unsigned)wid * 1024u;
    const int aoff = lds_byte(wr * 64 + fr, fq * 8), boff = lds_byte(wc * 32 + fr, fq * 8);
#define PG8_SA(b, h) (((b) * 2 + (h)) * HTB)
#define PG8_SB(b, h) ((4 + (b) * 2 + (h)) * HTB)
#define PG8_STAGE2(bufoff, gbase, v0, v1) do { \
        __builtin_amdgcn_global_load_lds((const unsigned*)((const char*)(gbase) + (v0)), (LAS unsigned*)(lds + (bufoff) + ldsw), 16, 0, 0); \
        __builtin_amdgcn_global_load_lds((const unsigned*)((const char*)(gbase) + (v1)), (LAS unsigned*)(lds + (bufoff) + ldsw + 8192), 16, 0, 0); } while (0)
#define PG8_STAGEA(bufoff, gbase) PG8_STAGE2(bufoff, gbase, voffA[0], voffA[1])
#define PG8_LDA(dst, b, h) do { _Pragma("unroll") for (int m = 0; m < 4; ++m) _Pragma("unroll") for (int k = 0; k < 2; ++k) dst[m][k] = *(const LAS bf16x8*)(lds + PG8_SA(b, h) + aoff + m * 2048 + k * 1024); } while (0)
#define PG8_LDB(dst, b, h) do { _Pragma("unroll") for (int n = 0; n < 2; ++n) _Pragma("unroll") for (int k = 0; k < 2; ++k) dst[n][k] = *(const LAS bf16x8*)(lds + PG8_SB(b, h) + boff + n * 2048 + k * 1024); } while (0)
#define PG8_MMA(ai, bj, At, Bt) do { __builtin_amdgcn_s_setprio(1); _Pragma("unroll") for (int m = 0; m < 4; ++m) _Pragma("unroll") for (int n = 0; n < 2; ++n) _Pragma("unroll") for (int k = 0; k < 2; ++k) \
        acc[ai][bj][m][n] = __builtin_amdgcn_mfma_f32_16x16x32_bf16(Bt[n][k], At[m][k], acc[ai][bj][m][n], 0, 0, 0); __builtin_amdgcn_s_setprio(0); } while (0)
#define PG8_WAIT_V(n) asm volatile("s_waitcnt vmcnt(" #n ")" ::: "memory")
#define PG8_WAIT_L(n) asm volatile("s_waitcnt lgkmcnt(" #n ")" ::: "memory")
#define PG8_BAR __builtin_amdgcn_s_barrier()
#define PG8_SCHED __builtin_amdgcn_sched_barrier(0)
    Unit cur, nxt; int ui = 0;
    if (!S.next(0, cur)) return;
    f32x4 acc[2][2][4][2];
#pragma unroll
    for (int a = 0; a < 2; ++a)
#pragma unroll
        for (int b = 0; b < 2; ++b)
#pragma unroll
            for (int m = 0; m < 4; ++m)
#pragma unroll
                for (int n = 0; n < 2; ++n) acc[a][b][m][n] = (f32x4){0.f, 0.f, 0.f, 0.f};
    bf16x8 At[4][2], B0[2][2], B1[2][2];
    const char* cA = cur.a; const char* cB = cur.b; const char* cBt = cur.bt;
    PG8_STAGE2(PG8_SB(0, 0), cB, voffB[0], voffB[1]); PG8_STAGE2(PG8_SB(0, 1), cB + hsBq, voffB[0], voffB[1]); PG8_STAGEA(PG8_SA(0, 0), cA); PG8_STAGEA(PG8_SA(0, 1), cA + hsA);
    if (wr == 1) PG8_BAR;
    PG8_WAIT_V(2); PG8_BAR;
    PG8_STAGE2(PG8_SB(1, 0), cB + kstep, voffB[0], voffB[1]); PG8_STAGEA(PG8_SA(1, 0), cA + kstep); PG8_STAGE2(PG8_SB(1, 1), cB + hsBq + kstep, voffB[0], voffB[1]);
    PG8_WAIT_V(6); PG8_BAR;
    for (;;) {
        const bool has_next = S.next(ui + 1, nxt);
        const char* nA = has_next ? nxt.a : cA; const char* nB = has_next ? nxt.b : cB;
        const int nt = cur.nt;
        for (int t = 0; t < nt; t += 2) {
            const bool last = (t == nt - 2);
            const char* a1 = cA + (long)(t + 1) * kstep;
            const char* a2 = last ? nA : cA + (long)(t + 2) * kstep;
            const char* a3 = a2 + kstep;
            const char* b2; long hsB; unsigned vb0, vb1;
            if (TOEP) {
                if (last) { b2 = nB; hsB = hsBq; vb0 = voffB[0]; vb1 = voffB[1]; }
                else { b2 = cBt + (long)t * kstep; hsB = hsBt; vb0 = voffT[0]; vb1 = voffT[1]; }
            } else { b2 = last ? nB : cB + (long)(t + 2) * kstep; hsB = hsBq; vb0 = voffB[0]; vb1 = voffB[1]; }
            const char* b3 = b2 + kstep;
            PG8_LDB(B0, 0, 0); PG8_LDB(B1, 0, 1); PG8_SCHED; PG8_LDA(At, 0, 0); PG8_STAGEA(PG8_SA(1, 1), a1 + hsA);
            PG8_WAIT_V(8); PG8_WAIT_L(0); PG8_BAR; PG8_MMA(0, 0, At, B0); PG8_MMA(0, 1, At, B1); PG8_BAR; PG8_SCHED;
            PG8_LDA(At, 0, 1); PG8_STAGE2(PG8_SB(0, 0), b2, vb0, vb1); PG8_STAGE2(PG8_SB(0, 1), b2 + hsB, vb0, vb1); PG8_STAGEA(PG8_SA(0, 0), a2);
            PG8_WAIT_V(8); PG8_WAIT_L(0); PG8_BAR; PG8_MMA(1, 0, At, B0); PG8_MMA(1, 1, At, B1); PG8_BAR; PG8_SCHED;
            PG8_LDB(B0, 1, 0); PG8_LDB(B1, 1, 1); PG8_SCHED; PG8_LDA(At, 1, 0); PG8_STAGEA(PG8_SA(0, 1), a2 + hsA);
            PG8_WAIT_V(8); PG8_WAIT_L(0); PG8_BAR; PG8_MMA(0, 0, At, B0); PG8_MMA(0, 1, At, B1); PG8_BAR; PG8_SCHED;
            PG8_LDA(At, 1, 1); PG8_STAGE2(PG8_SB(1, 0), b3, vb0, vb1); PG8_STAGE2(PG8_SB(1, 1), b3 + hsB, vb0, vb1); PG8_STAGEA(PG8_SA(1, 0), a3);
            PG8_WAIT_V(8); PG8_WAIT_L(0); PG8_BAR; PG8_MMA(1, 0, At, B0); PG8_MMA(1, 1, At, B1); PG8_BAR; PG8_SCHED;
        }
        if constexpr (ALIGN_EPI) { if (wr == 0) PG8_BAR; }
        E(acc, cur, wr, wc, fr, fq);
        if (!has_next) break;
#pragma unroll
        for (int a = 0; a < 2; ++a)
#pragma unroll
            for (int b = 0; b < 2; ++b)
#pragma unroll
                for (int m = 0; m < 4; ++m)
#pragma unroll
                    for (int n = 0; n < 2; ++n) acc[a][b][m][n] = (f32x4){0.f, 0.f, 0.f, 0.f};
        cur = nxt; cA = nA; cB = nB; cBt = nxt.bt; ++ui;
        if constexpr (ALIGN_EPI) { if (wr == 1) PG8_BAR; }
    }
    PG8_WAIT_V(0);
    if constexpr (!ALIGN_EPI) { if (wr == 0) PG8_BAR; }
    PG8_BAR;
#undef PG8_SA
#undef PG8_SB
#undef PG8_STAGE2
#undef PG8_STAGEA
#undef PG8_LDA
#undef PG8_LDB
#undef PG8_MMA
#undef PG8_WAIT_V
#undef PG8_WAIT_L
#undef PG8_BAR
#undef PG8_SCHED
}

__device__ __forceinline__ u32x4 pack8(const f32x4 v0, const f32x4 v1) { u32x4 w; w.x = cvt_pk_bf16(v0[0], v0[1]); w.y = cvt_pk_bf16(v0[2], v0[3]); w.z = cvt_pk_bf16(v1[0], v1[1]); w.w = cvt_pk_bf16(v1[2], v1[3]); return w; }
__device__ __forceinline__ void unpack8(const u32x4 w, f32x4& a, f32x4& b) { a = (f32x4){bflo(w.x), bfhi(w.x), bflo(w.y), bfhi(w.y)}; b = (f32x4){bflo(w.z), bfhi(w.z), bflo(w.w), bfhi(w.w)}; }

struct EpiInProj {
    static constexpr bool PERM = true;
    bf16_t* AU; bf16_t* ZZ; bf16_t* XBC;
    __device__ __forceinline__ void operator()(const f32x4 (&acc)[2][2][4][2], const Unit& u, int wr, int wc, int fr, int fq) const {
        const int row0 = u.pm * BM + wr * 64 + fr, colt = u.pn * BM + wc * 32 + 8 * fq;
#pragma unroll
        for (int ai = 0; ai < 2; ++ai)
#pragma unroll
            for (int m = 0; m < 4; ++m) { const int row = row0 + ai * HALF + m * 16;
#pragma unroll
                for (int bj = 0; bj < 2; ++bj) { const int col = colt + bj * HALF; const u32x4 w = pack8(acc[ai][bj][m][0], acc[ai][bj][m][1]);
                    bf16_t* dst;
                    if (u.pn < 4) dst = AU + ((size_t)((col >> 4) * 512 + (row >> 6)) * AUW + 128 + (row & 63) * 16 + (col & 15));
                    else if (u.pn < 12) dst = ZZ + (size_t)row * 2048 + (col - 1024);
                    else dst = XBC + (size_t)row * 2048 + (col - 3072);
                    *(u32x4*)dst = w; } }
    }
};
struct EpiBf16 {
    static constexpr bool PERM = true;
    bf16_t* O; int ldc;
    __device__ __forceinline__ void operator()(const f32x4 (&acc)[2][2][4][2], const Unit& u, int wr, int wc, int fr, int fq) const {
        const int row0 = u.pm * BM + wr * 64 + fr, col0 = u.pn * BM + wc * 32 + 8 * fq;
#pragma unroll
        for (int ai = 0; ai < 2; ++ai)
#pragma unroll
            for (int m = 0; m < 4; ++m) { bf16_t* rowp = O + (size_t)(row0 + ai * HALF + m * 16) * ldc + col0;
#pragma unroll
                for (int bj = 0; bj < 2; ++bj) *(u32x4*)(rowp + bj * HALF) = pack8(acc[ai][bj][m][0], acc[ai][bj][m][1]); }
    }
};
struct EpiGlu {
    static constexpr bool PERM = true;
    const bf16_t* Y; bf16_t* ZZ; const float* bias;
    __device__ __forceinline__ void operator()(const f32x4 (&acc)[2][2][4][2], const Unit& u, int wr, int wc, int fr, int fq) const {
        const int row0 = u.pm * BM + wr * 64 + fr, col0 = u.pn * BM + wc * 32 + 8 * fq;
        f32x4 bv[2][2];
#pragma unroll
        for (int bj = 0; bj < 2; ++bj) { bv[bj][0] = *(const f32x4*)(bias + col0 + bj * HALF); bv[bj][1] = *(const f32x4*)(bias + col0 + bj * HALF + 4); }
#pragma unroll
        for (int ai = 0; ai < 2; ++ai) {
            u32x4 yw[4][2], zw[4][2];
#pragma unroll
            for (int m = 0; m < 4; ++m)
#pragma unroll
                for (int bj = 0; bj < 2; ++bj) { const size_t row = (size_t)(row0 + ai * HALF + m * 16); const int col = col0 + bj * HALF;
                    yw[m][bj] = *(const u32x4*)(Y + row * 1024 + col); zw[m][bj] = *(const u32x4*)(ZZ + row * 2048 + col); }
#pragma unroll
            for (int m = 0; m < 4; ++m)
#pragma unroll
                for (int bj = 0; bj < 2; ++bj) { const size_t row = (size_t)(row0 + ai * HALF + m * 16); const int col = col0 + bj * HALF;
                    f32x4 y0, y1, z0, z1; unpack8(yw[m][bj], y0, y1); unpack8(zw[m][bj], z0, z1);
                    const f32x4 a0 = acc[ai][bj][m][0] + bv[bj][0], a1 = acc[ai][bj][m][1] + bv[bj][1]; f32x4 o0, o1;
#pragma unroll
                    for (int e = 0; e < 4; ++e) { o0[e] = y0[e] * sigmoidf_(a0[e]) * siluf_(z0[e]); o1[e] = y1[e] * sigmoidf_(a1[e]) * siluf_(z1[e]); }
                    *(u32x4*)(ZZ + row * 2048 + col) = pack8(o0, o1); }
            asm volatile("" ::: "memory");
        }
    }
};
struct EpiOut {
    static constexpr bool PERM = true;
    const bf16_t* XN; const float* RINV; bf16_t* Hb; float* SS;
    __device__ __forceinline__ void operator()(const f32x4 (&acc)[2][2][4][2], const Unit& u, int wr, int wc, int fr, int fq) const {
        const int row0 = u.pm * BM + wr * 64 + fr, col0 = u.pn * BM + wc * 32 + 8 * fq;
#pragma unroll
        for (int ai = 0; ai < 2; ++ai) {
            u32x4 xw[4][2]; float ri[4];
#pragma unroll
            for (int m = 0; m < 4; ++m) { const size_t row = (size_t)(row0 + ai * HALF + m * 16); ri[m] = RINV[row];
#pragma unroll
                for (int bj = 0; bj < 2; ++bj) xw[m][bj] = *(const u32x4*)(XN + row * 1024 + col0 + bj * HALF); }
#pragma unroll
            for (int m = 0; m < 4; ++m) { const size_t row = (size_t)(row0 + ai * HALF + m * 16); float ss = 0.f;
#pragma unroll
                for (int bj = 0; bj < 2; ++bj) { const int col = col0 + bj * HALF;
                    f32x4 x0, x1; unpack8(xw[m][bj], x0, x1);
                    const f32x4 h0 = acc[ai][bj][m][0] + x0 * ri[m], h1 = acc[ai][bj][m][1] + x1 * ri[m];
                    *(u32x4*)(Hb + row * 1024 + col) = pack8(h0, h1);
                    ss += ((h0[0] * h0[0] + h0[1] * h0[1]) + (h0[2] * h0[2] + h0[3] * h0[3])) + ((h1[0] * h1[0] + h1[1] * h1[1]) + (h1[2] * h1[2] + h1[3] * h1[3])); }
                ss += __shfl_xor(ss, 16); ss += __shfl_xor(ss, 32);
                if (fq == 0) SS[row * 16 + u.pn * 4 + wc] = ss; }
            asm volatile("" ::: "memory");
        }
    }
};
struct EpiGate {
    static constexpr bool PERM = false;
    float* H; const bf16_t* Hb; const bf16_t* PL; const float* SS1; float* SS2;
    __device__ __forceinline__ void operator()(const f32x4 (&acc)[2][2][4][2], const Unit& u, int wr, int wc, int fr, int fq) const {
        const int row0 = u.pm * BM + wr * 64 + fr, col0 = u.pn * BM + wc * 32 + 4 * fq;
#pragma unroll
        for (int ai = 0; ai < 2; ++ai)
#pragma unroll
            for (int m = 0; m < 4; ++m) { const size_t row = (size_t)(row0 + ai * HALF + m * 16);
                const f32x4 s0 = *(const f32x4*)(SS1 + row * 16), s1 = *(const f32x4*)(SS1 + row * 16 + 4), s2 = *(const f32x4*)(SS1 + row * 16 + 8), s3 = *(const f32x4*)(SS1 + row * 16 + 12);
                const f32x4 st = (s0 + s1) + (s2 + s3);
                const float r = rsqrtf(((st[0] + st[1]) + (st[2] + st[3])) * (1.f / 1024.f) + EPS);
                float ss = 0.f;
#pragma unroll
                for (int bj = 0; bj < 2; ++bj)
#pragma unroll
                    for (int n = 0; n < 2; ++n) { const int col = col0 + bj * HALF + n * 16;
                        const u32x2 hw = *(const u32x2*)(Hb + row * 1024 + col); const f32x4 h = (f32x4){bflo(hw.x), bfhi(hw.x), bflo(hw.y), bfhi(hw.y)}; const u32x2 pw = *(const u32x2*)(PL + row * 1024 + col);
                        const f32x4 pl = (f32x4){bflo(pw.x), bfhi(pw.x), bflo(pw.y), bfhi(pw.y)}; const f32x4 a = acc[ai][bj][m][n] * r; f32x4 o;
#pragma unroll
                        for (int e = 0; e < 4; ++e) o[e] = h[e] + pl[e] * sigmoidf_(a[e]);
                        *(f32x4*)(H + row * 1024 + col) = o;
                        ss += (o[0] * o[0] + o[1] * o[1]) + (o[2] * o[2] + o[3] * o[3]); }
                ss += __shfl_xor(ss, 16); ss += __shfl_xor(ss, 32);
                if (fq == 0) SS2[row * 16 + u.pn * 4 + wc] = ss;
                if (m & 1) asm volatile("" ::: "memory"); }
    }
};

struct EpiGateFinal {
    static constexpr bool PERM = true;
    float* OUT; const bf16_t* Hb; const bf16_t* PL; const float* SS1; float* XS; unsigned* cnt; const float* fw; LAS unsigned char* lx;
    __device__ __forceinline__ void operator()(f32x4 (&acc)[2][2][4][2], const Unit& u, int wr, int wc, int fr, int fq) const {
        const int tid = threadIdx.x, lane = tid & 63, wid = __builtin_amdgcn_readfirstlane(tid >> 6);
        LAS float* P = (LAS float*)(lx + 1024);
        LAS float* S = (LAS float*)(lx + 1024 + 4096);
        const int row0 = u.pm * BM + wr * 64 + fr, col0 = u.pn * BM + wc * 32 + 8 * fq;
#pragma unroll
        for (int ai = 0; ai < 2; ++ai) {
            f32x4 sq[4]; u32x4 hw[4][2], pw[4][2];
#pragma unroll
            for (int m = 0; m < 4; ++m) { const size_t row = (size_t)(row0 + ai * HALF + m * 16); sq[m] = *(const f32x4*)(SS1 + row * 16 + 4 * fq);
#pragma unroll
                for (int bj = 0; bj < 2; ++bj) { hw[m][bj] = *(const u32x4*)(Hb + row * 1024 + col0 + bj * HALF); pw[m][bj] = *(const u32x4*)(PL + row * 1024 + col0 + bj * HALF); } }
#pragma unroll
            for (int m = 0; m < 4; ++m) {
                float st = (sq[m][0] + sq[m][1]) + (sq[m][2] + sq[m][3]); st += __shfl_xor(st, 16); st += __shfl_xor(st, 32);
                const float r = rsqrtf(st * (1.f / 1024.f) + EPS);
                float ss = 0.f;
#pragma unroll
                for (int bj = 0; bj < 2; ++bj) {
                    f32x4 hh[2], pl[2]; unpack8(hw[m][bj], hh[0], hh[1]); unpack8(pw[m][bj], pl[0], pl[1]);
#pragma unroll
                    for (int n = 0; n < 2; ++n) { const f32x4 a = acc[ai][bj][m][n] * r; f32x4 o;
#pragma unroll
                        for (int e = 0; e < 4; ++e) o[e] = hh[n][e] + pl[n][e] * sigmoidf_(a[e]);
                        acc[ai][bj][m][n] = o;
                        ss += (o[0] * o[0] + o[1] * o[1]) + (o[2] * o[2] + o[3] * o[3]); } }
                ss += __shfl_xor(ss, 16); ss += __shfl_xor(ss, 32);
                if (fq == 0) P[(ai * HALF + wr * 64 + m * 16 + fr) * 4 + wc] = ss; }
            asm volatile("" ::: "memory");
        }
        asm volatile("s_waitcnt lgkmcnt(0)" ::: "memory"); __builtin_amdgcn_s_barrier(); asm volatile("" ::: "memory");
        if (tid < 256) { const f32x4 p4 = *(const LAS f32x4*)(P + tid * 4);
            __hip_atomic_store(XS + (size_t)(u.pm * BM + tid) * 4 + u.pn, (p4[0] + p4[1]) + (p4[2] + p4[3]), __ATOMIC_RELAXED, __HIP_MEMORY_SCOPE_AGENT); }
        asm volatile("s_waitcnt vmcnt(0)" ::: "memory");
        if (tid < 256 && lane == 0) __hip_atomic_fetch_add(cnt + 64 * u.pm, 1u, __ATOMIC_RELAXED, __HIP_MEMORY_SCOPE_AGENT);
        if (wid == 0) {
            unsigned sp = 0;
            while ((unsigned)__builtin_amdgcn_readfirstlane(__hip_atomic_load(cnt + 64 * u.pm, __ATOMIC_RELAXED, __HIP_MEMORY_SCOPE_AGENT)) < 16u) { __builtin_amdgcn_s_sleep(2); if (++sp > (1u << 22)) break; }
            __builtin_amdgcn_fence(__ATOMIC_ACQUIRE, "agent");
        }
        asm volatile("s_waitcnt vmcnt(0) lgkmcnt(0)" ::: "memory"); __builtin_amdgcn_s_barrier(); asm volatile("" ::: "memory");
        if (tid < 256) { const float* xs = XS + (size_t)(u.pm * BM + tid) * 4; float t = 0.f;
#pragma unroll
            for (int k = 0; k < 4; ++k) t += __hip_atomic_load(xs + k, __ATOMIC_RELAXED, __HIP_MEMORY_SCOPE_AGENT);
            S[tid] = rsqrtf(t * (1.f / 1024.f) + EPS); }
        asm volatile("s_waitcnt vmcnt(0) lgkmcnt(0)" ::: "memory"); __builtin_amdgcn_s_barrier(); asm volatile("" ::: "memory");
        f32x4 wv[2][2];
#pragma unroll
        for (int bj = 0; bj < 2; ++bj)
#pragma unroll
            for (int n = 0; n < 2; ++n) wv[bj][n] = *(const f32x4*)(fw + col0 + bj * HALF + n * 4);
#pragma unroll
        for (int ai = 0; ai < 2; ++ai)
#pragma unroll
            for (int m = 0; m < 4; ++m) { const int rl = ai * HALF + wr * 64 + m * 16 + fr; const float r2 = S[rl]; const size_t row = (size_t)(u.pm * BM + rl);
#pragma unroll
                for (int bj = 0; bj < 2; ++bj)
#pragma unroll
                    for (int n = 0; n < 2; ++n) *(f32x4*)(OUT + row * 1024 + col0 + bj * HALF + n * 4) = acc[ai][bj][m][n] * r2 * wv[bj][n]; }
    }
};

struct S5SOrder {
    int c; const char* AU; const char* P;
    __device__ bool next(int i, Unit& u) const {
        if (i != 0 || c >= 256) return false;
        const int g = c >> 2, pm = (c >> 1) & 1, kh = c & 1;
        u.pm = pm; u.pn = kh; u.g = g; u.nt = 8;
        u.a = AU + ((size_t)(g * 512 + pm * 256) * AUW + 128 + kh * 512) * 2; u.b = P + ((size_t)g * 128 * 1024 + kh * 512) * 2; u.bt = u.b; return true;
    }
};
struct EpiS5S {
    static constexpr bool PERM = false;
    float* S0; long half_stride;
    __device__ __forceinline__ void operator()(const f32x4 (&acc)[2][2][4][2], const Unit& u, int wr, int wc, int fr, int fq) const {
        float* S = S0 + (long)u.pn * half_stride + (size_t)(u.g * 512 + u.pm * 256) * 128;
        const int row0 = wr * 64 + fr, col0 = wc * 32 + 4 * fq;
#pragma unroll
        for (int ai = 0; ai < 2; ++ai)
#pragma unroll
            for (int m = 0; m < 4; ++m)
#pragma unroll
                for (int n = 0; n < 2; ++n) *(f32x4*)(S + (size_t)(row0 + ai * HALF + m * 16) * 128 + col0 + n * 16) = acc[ai][0][m][n];
    }
};
struct S5YOrder {
    int c; const char* AU; const char* Q; const char* KR;
    __device__ bool next(int i, Unit& u) const {
        if (i > 1 || c >= 256) return false;
        const int x = c & 7, k = c >> 3, lt = k >> 2;
        const int g = (x + 8 * (lt >> 2)) * 4 + (k & 3), pm = lt & 1, pair = (lt >> 1) & 1;
        const int pn = pair ? (i == 0 ? 1 : 2) : (i == 0 ? 0 : 3);
        u.pm = pm; u.pn = pn; u.g = g; u.nt = 4 * pn + 6;
        u.a = AU + (size_t)(g * 512 + pm * 256) * AUW * 2;
        u.b = Q + ((size_t)g * 1024 + pn * 256) * 128 * 2;
        u.bt = KR + (size_t)g * 65536 + (896 - pn * 256) * 2;
        return true;
    }
};
struct EpiS5Y {
    static constexpr bool PERM = true;
    bf16_t* Y;
    __device__ __forceinline__ void operator()(const f32x4 (&acc)[2][2][4][2], const Unit& u, int wr, int wc, int fr, int fq) const {
        const int row0 = u.pm * BM + wr * 64 + fr, col0 = u.pn * BM + wc * 32 + 8 * fq;
        const int h0 = col0 & 15;
#pragma unroll
        for (int ai = 0; ai < 2; ++ai)
#pragma unroll
            for (int m = 0; m < 4; ++m) { const int bc = row0 + ai * HALF + m * 16;
#pragma unroll
                for (int bj = 0; bj < 2; ++bj) { const int col = col0 + bj * HALF, t = col >> 4; f32x4 o0, o1;
#pragma unroll
                    for (int e = 0; e < 4; ++e) { o0[e] = gelu_tanh(acc[ai][bj][m][0][e]); o1[e] = gelu_tanh(acc[ai][bj][m][1][e]); }
                    *(u32x4*)(Y + (size_t)(bc * 64 + t) * 1024 + u.g * 16 + h0) = pack8(o0, o1); } }
    }
};
}

struct Args { const float* in[25]; float* out; unsigned char* ws; int ph_lo, ph_hi; };
enum { I_X = 0, I_P, I_NORMW, I_WIN, I_ARE, I_AIM, I_LOGDT, I_BRE, I_BIM, I_CRE, I_CIM, I_S5D, I_WGLU, I_BGLU, I_CONVW, I_CONVB, I_DTBIAS, I_ALOG, I_SSDD, I_SSDNW, I_WOUT, I_PLENW, I_WGATE, I_WPLE, I_FINALW };
constexpr int N_PHASES = 8;
#ifndef DBL_PHASE
#define DBL_PHASE -1
#endif

__device__ __forceinline__ void p0_transpose_item(const float* W, int ldw, int K, int N, bf16_t* WT, const float* sc, LAS float* scr, int item, int lane) {
    const int nblk = N / 32, kb = item / nblk, nb = item % nblk, k0 = 64 * kb, n0 = 32 * nb;
    float v[32];
#pragma unroll
    for (int i = 0; i < 32; ++i) v[i] = W[(size_t)(k0 + 2 * i + (lane >> 5)) * ldw + n0 + (lane & 31)];
    if (sc) {
        float s2[32];
#pragma unroll
        for (int i = 0; i < 32; ++i) s2[i] = sc[k0 + 2 * i + (lane >> 5)];
#pragma unroll
        for (int i = 0; i < 32; ++i) v[i] *= s2[i];
    }
#pragma unroll
    for (int i = 0; i < 32; ++i) scr[(2 * i + (lane >> 5)) * 33 + (lane & 31)] = v[i];
    asm volatile("s_waitcnt lgkmcnt(0)" ::: "memory");
    const int c = lane & 7;
#pragma unroll
    for (int j = 0; j < 4; ++j) { const int n = (lane >> 3) + 8 * j; const LAS float* s = scr + (8 * c) * 33 + n;
        u32x4 o; o.x = cvt_pk_bf16(s[0 * 33], s[1 * 33]); o.y = cvt_pk_bf16(s[2 * 33], s[3 * 33]); o.z = cvt_pk_bf16(s[4 * 33], s[5 * 33]); o.w = cvt_pk_bf16(s[6 * 33], s[7 * 33]);
        *(u32x4*)(WT + (size_t)(n0 + n) * K + k0 + 8 * c) = o; }
    asm volatile("s_waitcnt lgkmcnt(0)" ::: "memory");
}

__device__ __forceinline__ void p0_prologue(const Args& a, LAS unsigned char* lds, int vcu, int G) {
    const int tid = threadIdx.x, lane = tid & 63, wave = __builtin_amdgcn_readfirstlane(tid >> 6);
    unsigned char* ws = a.ws;
    LAS float* WD = (LAS float*)lds;
    LAS float* PWr = (LAS float*)(lds + 65536);
    LAS float* PWi = PWr + 65 * 64;
    LAS float* Cr = PWi + 65 * 64;
    LAS float* Ci = Cr + 1024;
    LAS float* Br = Ci + 1024;
    LAS float* Bi = Br + 1024;
    const int g = vcu >> 2, q = vcu & 3, t4 = tid - 256;
    if (wave < 4) {
        f32x4 wr_[4][4]; float nw_[4];
#pragma unroll
        for (int i = 0; i < 4; ++i) { const int k = tid + 256 * i; nw_[i] = a.in[I_NORMW][k];
#pragma unroll
            for (int c = 0; c < 4; ++c) wr_[i][c] = *(const f32x4*)(a.in[I_WIN] + (size_t)k * NPROJ + 5120 + 4 * c); }
#pragma unroll
        for (int i = 0; i < 4; ++i) { const int k = tid + 256 * i;
#pragma unroll
            for (int c = 0; c < 4; ++c) *(LAS f32x4*)(WD + ((((k >> 8) * 4 + (k & 3)) * 4 + c) * 64 + ((k >> 2) & 63)) * 4) = wr_[i][c] * nw_[i]; }
    } else if (vcu < 256) {
        const float dt = expf(a.in[I_LOGDT][g]);
        { const int n = t4 & 63; const float are = a.in[I_ARE][g * 64 + n] * dt, aim = a.in[I_AIM][g * 64 + n] * dt;
#pragma unroll
            for (int i = 0; i < 17; ++i) { const int tau = (t4 >> 6) + 4 * i; if (tau < 65) {
                const float mag = __expf(are * (float)tau); const float ang = aim * (float)tau; const float sn = __sinf(ang), cs = __cosf(ang);
                PWr[tau * 64 + n] = mag * cs; PWi[tau * 64 + n] = mag * sn; } } }
        for (int e = t4; e < 1024; e += 256) { const int h = e >> 6, n = e & 63; Cr[e] = a.in[I_CRE][(g * 16 + h) * 64 + n]; Ci[e] = a.in[I_CIM][(g * 16 + h) * 64 + n]; }
        for (int e = t4; e < 1024; e += 256) { const int n = e >> 4;
            const float are = a.in[I_ARE][g * 64 + n], aim = a.in[I_AIM][g * 64 + n];
            const float mag = expf(are * dt); float sn, cs; sincosf(aim * dt, &sn, &cs);
            const float nr = mag * cs - 1.f, ni = mag * sn, den = are * are + aim * aim;
            const float qr = (nr * are + ni * aim) / den, qi = (ni * are - nr * aim) / den;
            const float br = a.in[I_BRE][g * 1024 + e], bi = a.in[I_BIM][g * 1024 + e];
            Br[e] = qr * br - qi * bi; Bi[e] = qr * bi + qi * br; }
    }
    __syncthreads();
    if (wave >= 4) {
        if (vcu < 256) {
#pragma unroll 1
            for (int it = 0; it < 2; ++it) {
                const int vt = t4 + 256 * it;
                {
                    const int tau = 16 * q + (vt >> 5), h = (vt >> 1) & 15, hp0 = (vt & 1) * 8;
                    float s[8];
#pragma unroll
                    for (int j = 0; j < 8; ++j) s[j] = 0.f;
                    for (int n = 0; n < 64; ++n) { const float pr = PWr[tau * 64 + n], pi = PWi[tau * 64 + n], cr = Cr[h * 64 + n], ci = Ci[h * 64 + n];
                        const float xr = cr * pr - ci * pi, xi = cr * pi + ci * pr;
#pragma unroll
                        for (int j = 0; j < 8; ++j) s[j] += xr * Br[n * 16 + hp0 + j] - xi * Bi[n * 16 + hp0 + j]; }
                    if (tau == 0) { const float dv = a.in[I_S5D][g * 16 + h];
#pragma unroll
                        for (int j = 0; j < 8; ++j) if (hp0 + j == h) s[j] += dv; }
                    bf16_t* KR = (bf16_t*)(ws + WS_KR) + (size_t)g * 32768 + (size_t)h * 2048 + (63 - tau) * 16 + hp0;
                    u32x4 o; o.x = cvt_pk_bf16(s[0], s[1]); o.y = cvt_pk_bf16(s[2], s[3]); o.z = cvt_pk_bf16(s[4], s[5]); o.w = cvt_pk_bf16(s[6], s[7]);
                    *(u32x4*)KR = o;
                    bf16_t* KZ = (bf16_t*)(ws + WS_KR) + (size_t)g * 32768 + (size_t)(vt >> 5) * 2048 + (64 + 16 * q) * 16 + (vt & 31) * 8;
                    *(u32x4*)KZ = (u32x4){0u, 0u, 0u, 0u};
                }
                {
                    const int t = 16 * q + (vt >> 5), h = (vt >> 1) & 15, kh = vt & 1;
                    bf16_t* QP = (bf16_t*)(ws + WS_Q) + ((size_t)g * 1024 + t * 16 + h) * 128 + kh * 64;
#pragma unroll 2
                    for (int n0 = 0; n0 < 64; n0 += 8) { float v[8];
#pragma unroll
                        for (int j = 0; j < 8; ++j) { const int n = n0 + j; const float pr = PWr[(t + 1) * 64 + n], pi = PWi[(t + 1) * 64 + n], cr = Cr[h * 64 + n], ci = Ci[h * 64 + n];
                            v[j] = kh ? -(cr * pi + ci * pr) : (cr * pr - ci * pi); }
                        u32x4 o; o.x = cvt_pk_bf16(v[0], v[1]); o.y = cvt_pk_bf16(v[2], v[3]); o.z = cvt_pk_bf16(v[4], v[5]); o.w = cvt_pk_bf16(v[6], v[7]);
                        *(u32x4*)(QP + n0) = o; }
                }
                {
                    const int np = vt >> 2, n = np & 63, im = np >> 6, s0 = 16 * q + (vt & 3) * 4;
                    bf16_t* PP = (bf16_t*)(ws + WS_P) + ((size_t)g * 128 + np) * 1024 + s0 * 16;
#pragma unroll
                    for (int ds = 0; ds < 4; ++ds) { const int s = s0 + ds; const float pr = PWr[(63 - s) * 64 + n], pi = PWi[(63 - s) * 64 + n]; float v[16];
#pragma unroll
                        for (int j = 0; j < 16; ++j) { const float br = Br[n * 16 + j], bi = Bi[n * 16 + j]; v[j] = im ? (pr * bi + pi * br) : (pr * br - pi * bi); }
                        u32x4 o0, o1; o0.x = cvt_pk_bf16(v[0], v[1]); o0.y = cvt_pk_bf16(v[2], v[3]); o0.z = cvt_pk_bf16(v[4], v[5]); o0.w = cvt_pk_bf16(v[6], v[7]);
                        o1.x = cvt_pk_bf16(v[8], v[9]); o1.y = cvt_pk_bf16(v[10], v[11]); o1.z = cvt_pk_bf16(v[12], v[13]); o1.w = cvt_pk_bf16(v[14], v[15]);
                        *(u32x4*)(PP + ds * 16) = o0; *(u32x4*)(PP + ds * 16 + 8) = o1; }
                }
            }
            if (q == 0 && t4 < 64) { float* AB = (float*)(ws + WS_AB64) + (g * 64 + t4) * 2; AB[0] = PWr[64 * 64 + t4]; AB[1] = PWi[64 * 64 + t4]; }
        }
        LAS float* scr = (LAS float*)(lds + 115200 + (wave - 4) * 8448);
        const int gw = vcu * 4 + (wave - 4), NGW = G * 4;
        constexpr int I_IN = 16 * 160, I_GL = 16 * 32, I_OU = 32 * 32, I_GA = 16 * 32, I_PL = 4 * 32, NIT = I_IN + I_GL + I_OU + I_GA + I_PL;
        for (int it = gw; it < NIT; it += NGW) {
            int r = it;
            if (r < I_IN) { p0_transpose_item(a.in[I_WIN], NPROJ, 1024, 5120, (bf16_t*)(ws + WS_WIN), a.in[I_NORMW], scr, r, lane); continue; } r -= I_IN;
            if (r < I_GL) { p0_transpose_item(a.in[I_WGLU], 1024, 1024, 1024, (bf16_t*)(ws + WS_WGLU), nullptr, scr, r, lane); continue; } r -= I_GL;
            if (r < I_OU) { p0_transpose_item(a.in[I_WOUT], 1024, 2048, 1024, (bf16_t*)(ws + WS_WOUT), nullptr, scr, r, lane); continue; } r -= I_OU;
            if (r < I_GA) { p0_transpose_item(a.in[I_WGATE], 1024, 1024, 1024, (bf16_t*)(ws + WS_WGATE), a.in[I_PLENW], scr, r, lane); continue; } r -= I_GA;
            p0_transpose_item(a.in[I_WPLE], 1024, 256, 1024, (bf16_t*)(ws + WS_WPLE), nullptr, scr, r, lane);
        }
    } else {
        const int gw = vcu * 4 + wave, NGW = G * 4;
        const float* X = a.in[I_X]; bf16_t* XN = (bf16_t*)(ws + WS_XN); float* DT = (float*)(ws + WS_DT);
        const float bias = a.in[I_DTBIAS][(lane >> 1) & 15];
        f32x4 vn[2][4];
        if (gw < M / 2) {
#pragma unroll
            for (int rr = 0; rr < 2; ++rr)
#pragma unroll
                for (int j = 0; j < 4; ++j) vn[rr][j] = *((const f32x4*)(X + (size_t)(2 * gw + rr) * DM) + lane + 64 * j); }
        for (int pr = gw; pr < M / 2; pr += NGW) {
            f32x4 v[2][4]; float s0 = 0.f, s1 = 0.f;
#pragma unroll
            for (int j = 0; j < 4; ++j) { v[0][j] = vn[0][j]; v[1][j] = vn[1][j];
                s0 += (v[0][j][0] * v[0][j][0] + v[0][j][1] * v[0][j][1]) + (v[0][j][2] * v[0][j][2] + v[0][j][3] * v[0][j][3]);
                s1 += (v[1][j][0] * v[1][j][0] + v[1][j][1] * v[1][j][1]) + (v[1][j][2] * v[1][j][2] + v[1][j][3] * v[1][j][3]); }
            if (pr + NGW < M / 2) {
#pragma unroll
                for (int rr = 0; rr < 2; ++rr)
#pragma unroll
                    for (int j = 0; j < 4; ++j) vn[rr][j] = *((const f32x4*)(X + (size_t)(2 * (pr + NGW) + rr) * DM) + lane + 64 * j); }
            const float ms0 = wave_sum(s0) * (1.f / DM) + EPS, ms1 = wave_sum(s1) * (1.f / DM) + EPS; const float r0 = rsqrtf(ms0), r1_ = rsqrtf(ms1);
            if (lane < 2) ((float*)(ws + WS_RINV))[2 * pr + lane] = sqrtf(lane ? ms1 : ms0);
            u32x2* o8 = (u32x2*)(XN + (size_t)(2 * pr) * DM) + lane;
            float d0[16], d1[16];
#pragma unroll
            for (int h = 0; h < 16; ++h) { d0[h] = 0.f; d1[h] = 0.f; }
#pragma unroll
            for (int j = 0; j < 4; ++j) { v[0][j] = v[0][j] * r0; v[1][j] = v[1][j] * r1_;
                u32x2 w; w.x = cvt_pk_bf16(v[0][j][0], v[0][j][1]); w.y = cvt_pk_bf16(v[0][j][2], v[0][j][3]); o8[64 * j] = w;
                w.x = cvt_pk_bf16(v[1][j][0], v[1][j][1]); w.y = cvt_pk_bf16(v[1][j][2], v[1][j][3]); o8[256 + 64 * j] = w;
#pragma unroll
                for (int e = 0; e < 4; ++e)
#pragma unroll
                    for (int c = 0; c < 4; ++c) { const f32x4 wv = *(const LAS f32x4*)(WD + (((j * 4 + e) * 4 + c) * 64 + lane) * 4);
#pragma unroll
                        for (int i = 0; i < 4; ++i) { d0[4 * c + i] += v[0][j][e] * wv[i]; d1[4 * c + i] += v[1][j][e] * wv[i]; } } }
            const bool b5 = lane & 32, b4 = lane & 16, b3 = lane & 8, b2 = lane & 4, b1 = lane & 2;
            float q16[16], q8[8], q4[4], q2[2], q1;
#pragma unroll
            for (int i = 0; i < 16; ++i) { const float keep = b5 ? d1[i] : d0[i], send = b5 ? d0[i] : d1[i]; q16[i] = keep + __shfl_xor(send, 32); }
#pragma unroll
            for (int i = 0; i < 8; ++i) { const float keep = b4 ? q16[i + 8] : q16[i], send = b4 ? q16[i] : q16[i + 8]; q8[i] = keep + __shfl_xor(send, 16); }
#pragma unroll
            for (int i = 0; i < 4; ++i) { const float keep = b3 ? q8[i + 4] : q8[i], send = b3 ? q8[i] : q8[i + 4]; q4[i] = keep + __shfl_xor(send, 8); }
#pragma unroll
            for (int i = 0; i < 2; ++i) { const float keep = b2 ? q4[i + 2] : q4[i], send = b2 ? q4[i] : q4[i + 2]; q2[i] = keep + __shfl_xor(send, 4); }
            { const float keep = b1 ? q2[1] : q2[0], send = b1 ? q2[0] : q2[1]; q1 = keep + __shfl_xor(send, 2); }
            q1 += __shfl_xor(q1, 1);
            if ((lane & 1) == 0) DT[(size_t)(2 * pr + (lane >> 5)) * 16 + ((lane >> 1) & 15)] = softplusf_(q1 + bias);
        }
    }
    {
        const int gw = vcu * NWAVES + wave, NGW = G * NWAVES;
        const float* Pp = a.in[I_P]; bf16_t* PB = (bf16_t*)(ws + WS_PB);
        for (int m0 = gw; m0 < M; m0 += 8 * NGW) { f32x4 pv[8];
#pragma unroll
            for (int i = 0; i < 8; ++i) pv[i] = *((const f32x4*)(Pp + (size_t)(m0 + i * NGW) * PLE) + lane);
#pragma unroll
            for (int i = 0; i < 8; ++i) { u32x2 w; w.x = cvt_pk_bf16(pv[i][0], pv[i][1]); w.y = cvt_pk_bf16(pv[i][2], pv[i][3]); *((u32x2*)(PB + (size_t)(m0 + i * NGW) * PLE) + lane) = w; } }
    }
}

__device__ __forceinline__ void s5_chunk_scan(const Args& a) {
    const int tid = threadIdx.x;
    if (tid >= 64) return;
    const int n = tid;
    unsigned char* ws = a.ws;
    for (int blk = blockIdx.x; blk < 256; blk += gridDim.x) {
        const int g = blk >> 2, b = blk & 3;
        const float abr = ((const float*)(ws + WS_AB64))[(g * 64 + n) * 2], abi = ((const float*)(ws + WS_AB64))[(g * 64 + n) * 2 + 1];
        const float* S0 = (const float*)(ws + WS_S5S) + (size_t)(g * 512 + b * NCH) * 128;
        const float* S1 = (const float*)(ws + WS_S5S2) + (size_t)(g * 512 + b * NCH) * 128;
        bf16_t* AUp = (bf16_t*)(ws + WS_AU) + (size_t)(g * 512 + b * NCH) * AUW;
        float hr = 0.f, hi = 0.f;
        for (int c0 = 0; c0 < NCH; c0 += 32) {
            float sr[32], si[32];
#pragma unroll
            for (int j = 0; j < 32; ++j) { sr[j] = S0[(c0 + j) * 128 + n] + S1[(c0 + j) * 128 + n]; si[j] = S0[(c0 + j) * 128 + 64 + n] + S1[(c0 + j) * 128 + 64 + n]; }
#pragma unroll
            for (int j = 0; j < 32; ++j) { AUp[(size_t)(c0 + j) * AUW + n] = f2bf(hr); AUp[(size_t)(c0 + j) * AUW + 64 + n] = f2bf(hi);
                const float nr = abr * hr - abi * hi + sr[j], ni = abr * hi + abi * hr + si[j]; hr = nr; hi = ni; }
        }
    }
}

namespace ssd {
constexpr int XT_OFF = 0, XT_STRIDE = 144;
constexpr int CM_OFF = 36864, NM_STRIDE = 272;
constexpr int BM_OFF = 54272;
constexpr int SH_OFF = 71680;
constexpr int DTS_OFF = 108544, CSS_OFF = 109568, RED_OFF = 110592;
constexpr int BMT_OFF = 36864;

__device__ __forceinline__ int tsw(int r, int ck) { return r * XT_STRIDE + ((ck ^ ((r >> 3) & 7)) << 4); }
constexpr int WGT_OFF = 112640;

struct Raw { u32x4 x[7]; u32x4 bc[7]; float dt; };

__device__ __forceinline__ void load_weights(const Args& a, LAS unsigned char* lds, int g) {
    LAS float* W = (LAS float*)(lds + WGT_OFF);
    int tt = threadIdx.x; asm volatile("" : "+v"(tt));
    for (int e = tt; e < 2560; e += NTHR) { const int k = e >> 9, chl = e & 511;
        const int ch = chl < 256 ? g * 256 + chl : (chl < 384 ? 1024 + g * 128 + (chl - 256) : 1536 + g * 128 + (chl - 384));
        W[e] = k < 4 ? a.in[I_CONVW][k * 2048 + ch] : a.in[I_CONVB][ch]; }
    if (tt < 256) W[2560 + tt] = a.in[I_SSDNW][g * 256 + tt];
}
template <bool OUTP, int PART = 0>
__device__ __forceinline__ void load_raw(const Args& a, int u, Raw& raw) {
    const int tid = threadIdx.x, b = u >> 9, c = (u >> 2) & 127, g = u & 3;
    const size_t t0 = (size_t)b * SEQ + (size_t)c * 64;
    const bf16_t* XBC = (const bf16_t*)(a.ws + WS_XBC);
    const int wv = tid >> 6, l0 = ((((tid >> 3) & 7) + 8 * (wv & 1)) * 4), chx = g * 256 + ((tid & 7) + 8 * (wv >> 1)) * 8;
    const int chb = 1024 + (OUTP ? (tid >> 8) * 512 : 0) + g * 128 + ((tid & 7) + 8 * ((wv >> 1) & 1)) * 8;
    const bf16_t* px = XBC + ((long)t0 + l0 - 3) * 2048 + chx; const bf16_t* pb = XBC + ((long)t0 + l0 - 3) * 2048 + chb;
#pragma unroll
    for (int r = 0; r < 7; ++r) {
        if (PART != 2) raw.x[r] = *(const u32x4*)(px + r * 2048);
        if (PART != 1) { u32x4 wb = (u32x4){0u, 0u, 0u, 0u};
            if (OUTP || tid >= 256) wb = *(const u32x4*)(pb + r * 2048);
            raw.bc[r] = wb; } }
    if (PART != 2) { raw.dt = 0.f;
        if (tid < 256) raw.dt = ((const float*)(a.ws + WS_DT))[(t0 + (tid & 63)) * 16 + g * 4 + (tid >> 6)]; }
}
__device__ __forceinline__ void conv_regs(const u32x4 (&rw)[7], const LAS float* W, int chl, bool zlo, float (&o)[4][8]) {
    f32x4 w0[4], w1[4];
#pragma unroll
    for (int k = 0; k < 4; ++k) { w0[k] = *(const LAS f32x4*)(W + k * 512 + chl); w1[k] = *(const LAS f32x4*)(W + k * 512 + chl + 4); }
    const f32x4 b0 = *(const LAS f32x4*)(W + 2048 + chl), b1 = *(const LAS f32x4*)(W + 2048 + chl + 4);
    f32x4 s0[4], s1[4];
#pragma unroll
    for (int dl = 0; dl < 4; ++dl) { s0[dl] = b0; s1[dl] = b1; }
#pragma unroll
    for (int r = 0; r < 7; ++r) { f32x4 x0, x1; pg8::unpack8(rw[r], x0, x1);
        if (r < 3 && zlo) { x0 = (f32x4){0.f, 0.f, 0.f, 0.f}; x1 = (f32x4){0.f, 0.f, 0.f, 0.f}; }
#pragma unroll
        for (int dl = 0; dl < 4; ++dl) { const int k = r - dl; if (k >= 0 && k < 4) { s0[dl] += w0[k] * x0; s1[dl] += w1[k] * x1; } } }
#pragma unroll
    for (int dl = 0; dl < 4; ++dl)
#pragma unroll
        for (int e = 0; e < 4; ++e) { o[dl][e] = siluf_(s0[dl][e]); o[dl][4 + e] = siluf_(s1[dl][e]); }
}
__device__ __forceinline__ void dt_cs(LAS unsigned char* lds, float dtv, float negA) {
    const int tid = threadIdx.x, lane = tid & 63, h = tid >> 6;
    if (tid < 256) {
        float v = dtv * negA;
#pragma unroll
        for (int d = 1; d < 64; d <<= 1) { const float t = __shfl_up(v, d); if (lane >= d) v += t; }
        ((LAS float*)(lds + DTS_OFF))[h * 64 + lane] = dtv; ((LAS float*)(lds + CSS_OFF))[h * 64 + lane] = v;
    }
}
typedef __bf16 bf16x2_t __attribute__((ext_vector_type(2)));
__device__ __forceinline__ unsigned cvt2(float lo, float hi) { const f32x2 v = {lo, hi}; const bf16x2_t r = __builtin_convertvector(v, bf16x2_t); return __builtin_bit_cast(unsigned, r); }
__device__ __forceinline__ u32x2 pk4(float a, float b, float c, float d) { u32x2 w; w.x = cvt2(a, b); w.y = cvt2(c, d); return w; }

__device__ __forceinline__ int step_unit(int bx, int G, int s) { const int su = bx + (s >> 2) * G, j = s & 3; return ((su >> 7) << 9) | ((((su >> 2) & 31) * 4 + j) << 2) | (su & 3); }

__device__ __forceinline__ void states_unit(const Args& a, LAS unsigned char* lds, int u, int un, int& gl, float& negA, Raw& cur, f32x4 (&acc)[2][8], float& dprod) {
    const int tid = threadIdx.x, lane = tid & 63, wave = __builtin_amdgcn_readfirstlane(tid >> 6), fr = lane & 15, fq = lane >> 4;
    const LAS float* DTS = (const LAS float*)(lds + DTS_OFF); const LAS float* CSS = (const LAS float*)(lds + CSS_OFF); const LAS float* W = (const LAS float*)(lds + WGT_OFF);
    const int b = u >> 9, c = (u >> 2) & 127, g = u & 3, j = c & 3;
    __syncthreads();
    if (g != gl) { load_weights(a, lds, g); gl = g; negA = -expf(a.in[I_ALOG][g * 4 + ((tid >> 6) & 3)]); }
    dt_cs(lds, cur.dt, negA);
    __syncthreads();
    {
        const int oct = (tid & 7) + 8 * (wave >> 1), run = ((tid >> 3) & 7) + 8 * (wave & 1), l0 = run * 4, hh = oct >> 3; float o[4][8];
        conv_regs(cur.x, W, oct * 8, c == 0 && run == 0, o);
        asm volatile("" ::: "memory");
        if (un >= 0) load_raw<false, 1>(a, un, cur);
        float sc[4]; const float ce = CSS[hh * 64 + 63];
#pragma unroll
        for (int dl = 0; dl < 4; ++dl) sc[dl] = DTS[hh * 64 + l0 + dl] * __expf(ce - CSS[hh * 64 + l0 + dl]);
#pragma unroll
        for (int jj = 0; jj < 8; ++jj) *(LAS u32x2*)(lds + XT_OFF + tsw(oct * 8 + jj, run >> 1) + (run & 1) * 8) = pk4(o[0][jj] * sc[0], o[1][jj] * sc[1], o[2][jj] * sc[2], o[3][jj] * sc[3]);
    }
    if (tid >= 256) {
        const int oct = (tid & 7) + 8 * ((wave >> 1) & 1), run = ((tid >> 3) & 7) + 8 * (wave & 1); float o[4][8];
        conv_regs(cur.bc, W, 256 + oct * 8, c == 0 && run == 0, o);
#pragma unroll
        for (int jj = 0; jj < 8; ++jj) *(LAS u32x2*)(lds + BMT_OFF + tsw(oct * 8 + jj, run >> 1) + (run & 1) * 8) = pk4(o[0][jj], o[1][jj], o[2][jj], o[3][jj]);
    }
    asm volatile("" ::: "memory");
    if (un >= 0) load_raw<false, 2>(a, un, cur);
    __syncthreads();
    const int h = wave >> 1, ph = wave & 1;
    const float dec = __expf(CSS[h * 64 + 63]);
    if (j == 0) { dprod = dec;
#pragma unroll
        for (int pi = 0; pi < 2; ++pi)
#pragma unroll
            for (int nj = 0; nj < 8; ++nj) acc[pi][nj] = (f32x4){0.f, 0.f, 0.f, 0.f};
    } else { dprod *= dec;
#pragma unroll
        for (int pi = 0; pi < 2; ++pi)
#pragma unroll
            for (int nj = 0; nj < 8; ++nj) acc[pi][nj] = acc[pi][nj] * dec; }
#pragma unroll
    for (int ks = 0; ks < 2; ++ks) { bf16x8 xf[2];
#pragma unroll
        for (int pi = 0; pi < 2; ++pi) xf[pi] = *(const LAS bf16x8*)(lds + XT_OFF + tsw(h * 64 + ph * 32 + pi * 16 + fr, ks * 4 + fq));
#pragma unroll
        for (int nj = 0; nj < 8; ++nj) { const bf16x8 bf = *(const LAS bf16x8*)(lds + BMT_OFF + tsw(nj * 16 + fr, ks * 4 + fq));
#pragma unroll
            for (int pi = 0; pi < 2; ++pi) acc[pi][nj] = __builtin_amdgcn_mfma_f32_16x16x32_bf16(bf, xf[pi], acc[pi][nj], 0, 0, 0); } }
    if (j == 3) {
        bf16_t* STp = (bf16_t*)a.out + ((size_t)(b * NSC + (c >> 2)) * 16 + g * 4 + h) * 8192;
#pragma unroll
        for (int pi = 0; pi < 2; ++pi)
#pragma unroll
            for (int nj = 0; nj < 8; ++nj) *(u32x2*)(STp + (ph * 32 + pi * 16 + fr) * 128 + nj * 16 + 4 * fq) = pk4(acc[pi][nj][0], acc[pi][nj][1], acc[pi][nj][2], acc[pi][nj][3]);
        if (ph == 0 && lane == 0) ((float*)(a.ws + WS_CD))[(b * NSC + (c >> 2)) * 16 + g * 4 + h] = dprod;
    }
}
__device__ __forceinline__ void states_phase(const Args& a, LAS unsigned char* lds, int bx, int G) {
    const int NSU = NB * NSC * 4;
    if (bx >= NSU) return;
    const int nsteps = 4 * ((NSU - bx + G - 1) / G);
    Raw ra; load_raw<false>(a, step_unit(bx, G, 0), ra);
    f32x4 acc[2][8]; float dprod = 1.f;
#pragma unroll
    for (int pi = 0; pi < 2; ++pi)
#pragma unroll
        for (int nj = 0; nj < 8; ++nj) acc[pi][nj] = (f32x4){0.f, 0.f, 0.f, 0.f};
    int gl = -1; float negA = 0.f;
    for (int s = 0; s < nsteps; ++s) states_unit(a, lds, step_unit(bx, G, s), (s + 1 < nsteps) ? step_unit(bx, G, s + 1) : -1, gl, negA, ra, acc, dprod);
}

__device__ __forceinline__ void state_scan(const Args& a) {
    const int tid = threadIdx.x;
    const float* CD = (const float*)(a.ws + WS_CD);
    for (int gt = blockIdx.x * NTHR + tid; gt < NB * 32768; gt += gridDim.x * NTHR) {
        const int b = gt >> 15, rem = gt & 32767, h = rem >> 11;
        bf16_t* base = (bf16_t*)a.out + (size_t)b * NSC * 131072 + (size_t)rem * 4;
        f32x4 st = (f32x4){0.f, 0.f, 0.f, 0.f};
        for (int c0 = 0; c0 < NSC; c0 += 16) {
            u32x2 lw[16]; float dc[16];
#pragma unroll
            for (int j = 0; j < 16; ++j) { lw[j] = *(const u32x2*)(base + (size_t)(c0 + j) * 131072); dc[j] = CD[(b * NSC + c0 + j) * 16 + h]; }
#pragma unroll
            for (int j = 0; j < 16; ++j) { *(u32x2*)(base + (size_t)(c0 + j) * 131072) = pk4(st[0], st[1], st[2], st[3]);
                const f32x4 lv = (f32x4){bflo(lw[j].x), bfhi(lw[j].x), bflo(lw[j].y), bfhi(lw[j].y)}; st = st * dc[j] + lv; }
        }
    }
}

constexpr int BMT2_OFF = 123904;

struct Late { bf16x8 pf[2][4]; u32x2 zw[4][2]; };
__device__ __forceinline__ bf16x8 cat8(const u32x2 lo, const u32x2 hi) { const u32x4 w = (u32x4){lo.x, lo.y, hi.x, hi.y}; return __builtin_bit_cast(bf16x8, w); }
__device__ __forceinline__ void load_state(const Args& a, int u, int h, int ph, int fr, int fq, Late& L) {
    const int b = u >> 9, c = (u >> 2) & 127, g = u & 3;
    const bf16_t* STp = (const bf16_t*)a.out + ((size_t)(b * NSC + (c >> 2)) * 16 + g * 4 + h) * 8192;
#pragma unroll
    for (int pt = 0; pt < 2; ++pt)
#pragma unroll
        for (int ks = 0; ks < 4; ++ks) { const bf16_t* p = STp + (ph * 32 + pt * 16 + fr) * 128 + ks * 32 + 4 * fq;
            L.pf[pt][ks] = cat8(*(const u32x2*)p, *(const u32x2*)(p + 16)); }
}
__device__ __forceinline__ void load_z(const Args& a, int u, int h, int ph, int fr, int fq, Late& L) {
    const int b = u >> 9, c = (u >> 2) & 127, g = u & 3;
    const size_t t0 = (size_t)b * SEQ + (size_t)c * 64;
    const bf16_t* ZZ = (const bf16_t*)(a.ws + WS_ZZ);
#pragma unroll
    for (int mi = 0; mi < 4; ++mi)
#pragma unroll
        for (int nj = 0; nj < 2; ++nj) L.zw[mi][nj] = *(const u32x2*)(ZZ + (t0 + mi * 16 + fr) * 2048 + 1024 + g * 256 + h * 64 + ph * 32 + nj * 16 + 4 * fq);
}
__device__ __forceinline__ void out_unit(const Args& a, LAS unsigned char* lds, int u, int un, int& gl, float& negA, Raw& cur, Late& L) {
    const int tid = threadIdx.x, lane = tid & 63, wave = __builtin_amdgcn_readfirstlane(tid >> 6), fr = lane & 15, fq = lane >> 4;
    bf16_t* ZZ = (bf16_t*)(a.ws + WS_ZZ);
    const LAS float* DTS = (const LAS float*)(lds + DTS_OFF); const LAS float* CSS = (const LAS float*)(lds + CSS_OFF); LAS float* RED = (LAS float*)(lds + RED_OFF);
    const LAS float* W = (const LAS float*)(lds + WGT_OFF);
    const int h = wave >> 1, ph = wave & 1;
    const int b = u >> 9, c = (u >> 2) & 127, g = u & 3, j = c & 3;
    const size_t t0 = (size_t)b * SEQ + (size_t)c * 64;
    __syncthreads();
    if (j == 0) load_state(a, u, h, ph, fr, fq, L);
    if (g != gl) { load_weights(a, lds, g); gl = g; negA = -expf(a.in[I_ALOG][g * 4 + ((tid >> 6) & 3)]); __syncthreads(); }
    dt_cs(lds, cur.dt, negA);
    {
        const int oct = (tid & 7) + 8 * (wave >> 1), run = ((tid >> 3) & 7) + 8 * (wave & 1); float o[4][8];
        conv_regs(cur.x, W, oct * 8, c == 0 && run == 0, o);
        asm volatile("" ::: "memory");
        if (un >= 0) load_raw<true, 1>(a, un, cur);
#pragma unroll
        for (int jj = 0; jj < 8; ++jj) *(LAS u32x2*)(lds + XT_OFF + tsw(oct * 8 + jj, run >> 1) + (run & 1) * 8) = pk4(o[0][jj], o[1][jj], o[2][jj], o[3][jj]);
    }
    {
        const int sel = tid >> 8, oct = (tid & 7) + 8 * ((wave >> 1) & 1), run = ((tid >> 3) & 7) + 8 * (wave & 1), l0 = run * 4; float o[4][8];
        conv_regs(cur.bc, W, 256 + sel * 128 + oct * 8, c == 0 && run == 0, o);
        const int off = sel ? CM_OFF : BM_OFF;
#pragma unroll
        for (int dl = 0; dl < 4; ++dl) { u32x4 w; w.x = cvt2(o[dl][0], o[dl][1]); w.y = cvt2(o[dl][2], o[dl][3]); w.z = cvt2(o[dl][4], o[dl][5]); w.w = cvt2(o[dl][6], o[dl][7]);
            *(LAS u32x4*)(lds + off + (l0 + dl) * NM_STRIDE + oct * 16) = w; }
        if (sel == 0 && j < 3) {
#pragma unroll
            for (int jj = 0; jj < 8; ++jj) *(LAS u32x2*)(lds + BMT2_OFF + tsw(oct * 8 + jj, run >> 1) + (run & 1) * 8) = pk4(o[0][jj], o[1][jj], o[2][jj], o[3][jj]); }
    }
    asm volatile("" ::: "memory");
    if (un >= 0) load_raw<true, 2>(a, un, cur);
    load_z(a, u, h, ph, fr, fq, L);
    __syncthreads();
    {
        const int mi = wave >> 1, nj0 = (wave & 1) * 2;
        f32x4 accG[2] = {(f32x4){0.f, 0.f, 0.f, 0.f}, (f32x4){0.f, 0.f, 0.f, 0.f}};
#pragma unroll
        for (int ks = 0; ks < 4; ++ks) { const bf16x8 cf = *(const LAS bf16x8*)(lds + CM_OFF + (mi * 16 + fr) * NM_STRIDE + (ks * 32 + fq * 8) * 2);
#pragma unroll
            for (int jj = 0; jj < 2; ++jj) { const bf16x8 bf = *(const LAS bf16x8*)(lds + BM_OFF + ((nj0 + jj) * 16 + fr) * NM_STRIDE + (ks * 32 + fq * 8) * 2);
                accG[jj] = __builtin_amdgcn_mfma_f32_16x16x32_bf16(bf, cf, accG[jj], 0, 0, 0); } }
        const int l = mi * 16 + fr;
#pragma unroll
        for (int hh = 0; hh < 4; ++hh) { const float csl = CSS[hh * 64 + l];
#pragma unroll
            for (int jj = 0; jj < 2; ++jj) { const int s0 = (nj0 + jj) * 16 + 4 * fq;
                const f32x4 css = *(const LAS f32x4*)(CSS + hh * 64 + s0), dts = *(const LAS f32x4*)(DTS + hh * 64 + s0); float v[4];
#pragma unroll
                for (int e = 0; e < 4; ++e) v[e] = (s0 + e <= l) ? accG[jj][e] * __expf(csl - css[e]) * dts[e] : 0.f;
                *(LAS u32x2*)(lds + SH_OFF + hh * 9216 + l * XT_STRIDE + s0 * 2) = pk4(v[0], v[1], v[2], v[3]); } }
    }
    __syncthreads();
    const float Dh = a.in[I_SSDD][g * 4 + h];
    f32x4 gv[4][2];
#pragma unroll
    for (int half = 0; half < 2; ++half) {
        f32x4 accD[2][2], accO[2][2];
#pragma unroll
        for (int mm = 0; mm < 2; ++mm)
#pragma unroll
            for (int nj = 0; nj < 2; ++nj) { accD[mm][nj] = (f32x4){0.f, 0.f, 0.f, 0.f}; accO[mm][nj] = (f32x4){0.f, 0.f, 0.f, 0.f}; }
#pragma unroll
        for (int ks = 0; ks < 2; ++ks) { bf16x8 xf[2];
#pragma unroll
            for (int nj = 0; nj < 2; ++nj) xf[nj] = *(const LAS bf16x8*)(lds + XT_OFF + tsw(h * 64 + ph * 32 + nj * 16 + fr, ks * 4 + fq));
#pragma unroll
            for (int mm = 0; mm < 2; ++mm) { const bf16x8 sf = *(const LAS bf16x8*)(lds + SH_OFF + h * 9216 + ((half * 2 + mm) * 16 + fr) * XT_STRIDE + (ks * 32 + fq * 8) * 2);
#pragma unroll
                for (int nj = 0; nj < 2; ++nj) accD[mm][nj] = __builtin_amdgcn_mfma_f32_16x16x32_bf16(xf[nj], sf, accD[mm][nj], 0, 0, 0); } }
#pragma unroll
        for (int ks = 0; ks < 4; ++ks)
#pragma unroll
            for (int mm = 0; mm < 2; ++mm) { const LAS unsigned char* cp = lds + CM_OFF + ((half * 2 + mm) * 16 + fr) * NM_STRIDE + (ks * 32 + 4 * fq) * 2;
                const bf16x8 cf = cat8(*(const LAS u32x2*)cp, *(const LAS u32x2*)(cp + 32));
#pragma unroll
                for (int nj = 0; nj < 2; ++nj) accO[mm][nj] = __builtin_amdgcn_mfma_f32_16x16x32_bf16(L.pf[nj][ks], cf, accO[mm][nj], 0, 0, 0); }
#pragma unroll
        for (int mm = 0; mm < 2; ++mm) { const int mi = half * 2 + mm, l = mi * 16 + fr; const float el = __expf(CSS[h * 64 + l]); float ss = 0.f;
#pragma unroll
            for (int nj = 0; nj < 2; ++nj) { const int p0 = ph * 32 + nj * 16 + 4 * fq;
                const f32x4 z = (f32x4){bflo(L.zw[mi][nj].x), bfhi(L.zw[mi][nj].x), bflo(L.zw[mi][nj].y), bfhi(L.zw[mi][nj].y)};
#pragma unroll
                for (int e = 0; e < 4; ++e) { const float xv = bf2f(*(const LAS unsigned short*)(lds + XT_OFF + tsw(h * 64 + p0 + e, l >> 3) + (l & 7) * 2));
                    const float y = accD[mm][nj][e] + el * accO[mm][nj][e] + Dh * xv; const float gg = y * siluf_(z[e]); gv[mi][nj][e] = gg; ss += gg * gg; } }
            ss += __shfl_xor(ss, 16); ss += __shfl_xor(ss, 32);
            if (fq == 0) RED[wave * 64 + l] = ss; }
        asm volatile("" ::: "memory");
    }
    __syncthreads();
#pragma unroll
    for (int mi = 0; mi < 4; ++mi) { const int l = mi * 16 + fr; float tot = 0.f;
#pragma unroll
        for (int w = 0; w < 8; ++w) tot += RED[w * 64 + l];
        const float r = rsqrtf(tot * (1.f / 256.f) + EPS);
#pragma unroll
        for (int nj = 0; nj < 2; ++nj) { const int p0 = ph * 32 + nj * 16 + 4 * fq; const f32x4 nw = *(const LAS f32x4*)(W + 2560 + h * 64 + p0);
            *(u32x2*)(ZZ + (t0 + l) * 2048 + 1024 + g * 256 + h * 64 + p0) = pk4(gv[mi][nj][0] * r * nw[0], gv[mi][nj][1] * r * nw[1], gv[mi][nj][2] * r * nw[2], gv[mi][nj][3] * r * nw[3]); } }
    if (j < 3) {
        const float ce = CSS[h * 64 + 63], dec = __expf(ce);
#pragma unroll
        for (int pt = 0; pt < 2; ++pt) {
            f32x4 as[8];
#pragma unroll
            for (int ks = 0; ks < 4; ++ks) { const u32x4 w = __builtin_bit_cast(u32x4, L.pf[pt][ks]);
                as[2 * ks] = (f32x4){bflo(w.x), bfhi(w.x), bflo(w.y), bfhi(w.y)} * dec; as[2 * ks + 1] = (f32x4){bflo(w.z), bfhi(w.z), bflo(w.w), bfhi(w.w)} * dec; }
#pragma unroll
            for (int k2 = 0; k2 < 2; ++k2) {
                const u32x4 xw = *(const LAS u32x4*)(lds + XT_OFF + tsw(h * 64 + ph * 32 + pt * 16 + fr, k2 * 4 + fq));
                const int lb = h * 64 + k2 * 32 + fq * 8;
                const f32x4 d0 = *(const LAS f32x4*)(DTS + lb), d1 = *(const LAS f32x4*)(DTS + lb + 4), c0 = *(const LAS f32x4*)(CSS + lb), c1 = *(const LAS f32x4*)(CSS + lb + 4);
                f32x4 x0, x1; pg8::unpack8(xw, x0, x1);
#pragma unroll
                for (int e = 0; e < 4; ++e) { x0[e] *= d0[e] * __expf(ce - c0[e]); x1[e] *= d1[e] * __expf(ce - c1[e]); }
                const u32x4 xs = (u32x4){cvt2(x0[0], x0[1]), cvt2(x0[2], x0[3]), cvt2(x1[0], x1[1]), cvt2(x1[2], x1[3])};
                const bf16x8 xf = __builtin_bit_cast(bf16x8, xs);
#pragma unroll
                for (int nt = 0; nt < 8; ++nt) { const bf16x8 bf = *(const LAS bf16x8*)(lds + BMT2_OFF + tsw(nt * 16 + fr, k2 * 4 + fq));
                    as[nt] = __builtin_amdgcn_mfma_f32_16x16x32_bf16(bf, xf, as[nt], 0, 0, 0); } }
#pragma unroll
            for (int ks = 0; ks < 4; ++ks) { const u32x4 w = (u32x4){cvt2(as[2 * ks][0], as[2 * ks][1]), cvt2(as[2 * ks][2], as[2 * ks][3]), cvt2(as[2 * ks + 1][0], as[2 * ks + 1][1]), cvt2(as[2 * ks + 1][2], as[2 * ks + 1][3])};
                L.pf[pt][ks] = __builtin_bit_cast(bf16x8, w); }
        }
    }
}
__device__ __forceinline__ void out_phase(const Args& a, LAS unsigned char* lds, int bx, int G) {
    const int NSU = NB * NSC * 4;
    if (bx >= NSU) return;
    const int nsteps = 4 * ((NSU - bx + G - 1) / G);
    Raw ra; Late L;
    load_raw<true>(a, step_unit(bx, G, 0), ra);
#pragma unroll
    for (int pt = 0; pt < 2; ++pt)
#pragma unroll
        for (int ks = 0; ks < 4; ++ks) L.pf[pt][ks] = (bf16x8){0, 0, 0, 0, 0, 0, 0, 0};
    int gl = -1; float negA = 0.f;
    for (int s = 0; s < nsteps; ++s) out_unit(a, lds, step_unit(bx, G, s), (s + 1 < nsteps) ? step_unit(bx, G, s + 1) : -1, gl, negA, ra, L);
}
}

__device__ __forceinline__ void final_norm(const Args& a, int vcu, int G) {
    const int tid = threadIdx.x, lane = tid & 63, wave = tid >> 6;
    const float* SS2 = (const float*)(a.ws + WS_SS2);
    const int gw = vcu * NWAVES + wave, NGW = G * NWAVES;
    f32x4 wv[4];
#pragma unroll
    for (int j = 0; j < 4; ++j) wv[j] = *((const f32x4*)a.in[I_FINALW] + lane + 64 * j);
    for (int m = gw; m < M; m += NGW) {
        const f32x4 s0 = *(const f32x4*)(SS2 + (size_t)m * 16), s1 = *(const f32x4*)(SS2 + (size_t)m * 16 + 4), s2 = *(const f32x4*)(SS2 + (size_t)m * 16 + 8), s3 = *(const f32x4*)(SS2 + (size_t)m * 16 + 12);
        const f32x4 st = (s0 + s1) + (s2 + s3);
        const float r = rsqrtf(((st[0] + st[1]) + (st[2] + st[3])) * (1.f / 1024.f) + EPS);
        f32x4* o = (f32x4*)(a.out + (size_t)m * DM) + lane;
#pragma unroll
        for (int j = 0; j < 4; ++j) { const f32x4 h = o[64 * j]; o[64 * j] = h * r * wv[j]; }
    }
}

__global__ void __launch_bounds__(NTHR, 2) mega_fwd(Args args) {
    extern __shared__ __attribute__((aligned(16))) unsigned char lds_raw[];
    LAS unsigned char* lds = (LAS unsigned char*)lds_raw;
    const int tid = threadIdx.x;
    const int G = gridDim.x; const int bx = blockIdx.x; const int vcu = (G % 8 == 0) ? (bx % 8) * (G / 8) + bx / 8 : bx;
    unsigned char* ws = args.ws;
    unsigned* ctl = (unsigned*)(ws + WS_CTL);
    for (int u = tid; u < (LDS_BYTES - LDSCTL_OFF) / 4; u += NTHR) ((LAS unsigned*)(lds + LDSCTL_OFF))[u] = 0u;
    __syncthreads();
    XcdBarrier bar; bar.bar = ctl + 4096; bar.x = 0; bar.st = nullptr;
    if (MK_N_LAUNCHES == 1) bar = xcd_barrier_post(ctl + 4096, (volatile LAS unsigned*)(lds + LDSCTL_OFF + 64));
    const int lo = args.ph_lo, hi = args.ph_hi;
#define IN(k) (lo <= (k) && (k) < hi)
#define SEAM(k) do { if (IN(k) && IN((k) + 1)) xcd_barrier(bar); } while (0)

    if (IN(0)) { for (int rep = 0; rep < (DBL_PHASE == 0 ? 2 : 1); ++rep) { p0_prologue(args, lds, vcu, G); if (DBL_PHASE == 0 && rep == 0) xcd_barrier(bar); } } SEAM(0);
    if (IN(1)) for (int rep = 0; rep < (DBL_PHASE == 1 ? 2 : 1); ++rep) {
        if (rep) xcd_barrier(bar);
        pg8::PlainOrder S; S.init(M, 5120, G, bx, ws + WS_XN, 2048, ws + WS_WIN, 2048, 16);
        pg8::EpiInProj E{(bf16_t*)(ws + WS_AU), (bf16_t*)(ws + WS_ZZ), (bf16_t*)(ws + WS_XBC)};
        pg8::gemm_phase<pg8::EpiInProj, pg8::PlainOrder, true, false>(lds, S, E, 2048, 2048);
    } SEAM(1);
    if (IN(2)) for (int rep = 0; rep < (DBL_PHASE == 2 ? 2 : 1); ++rep) {
        if (rep) xcd_barrier(bar);
        pg8::S5SOrder S{bx, (const char*)(ws + WS_AU), (const char*)(ws + WS_P)};
        pg8::EpiS5S E{(float*)(ws + WS_S5S), (long)((WS_S5S2 - WS_S5S) / 4)};
        pg8::gemm_phase<pg8::EpiS5S, pg8::S5SOrder, false, false>(lds, S, E, AUW * 2, 2048);
        if (__builtin_amdgcn_readfirstlane(tid) >= 256) __builtin_amdgcn_s_setprio(1);
        ssd::states_phase(args, lds, bx, G);
        __builtin_amdgcn_s_setprio(0);
    } SEAM(2);
    if (IN(3)) { s5_chunk_scan(args); ssd::state_scan(args); } SEAM(3);
    if (IN(4)) {
        pg8::S5YOrder S{bx, (const char*)(ws + WS_AU), (const char*)(ws + WS_Q), (const char*)(ws + WS_KR)};
        pg8::EpiS5Y E{(bf16_t*)((unsigned char*)args.out + YPRE_OFF)};
        pg8::gemm_phase<pg8::EpiS5Y, pg8::S5YOrder, true, true>(lds, S, E, AUW * 2, 256);
        if (__builtin_amdgcn_readfirstlane(tid) >= 256) __builtin_amdgcn_s_setprio(1);
        ssd::out_phase(args, lds, bx, G);
        __builtin_amdgcn_s_setprio(0);
    } SEAM(4);
    if (IN(5)) {
#define P5_GLU() do { pg8::PlainOrder S; S.init(M, 1024, G, bx, (unsigned char*)args.out + YPRE_OFF, 2048, ws + WS_WGLU, 2048, 16); \
            pg8::EpiGlu E{(const bf16_t*)((unsigned char*)args.out + YPRE_OFF), (bf16_t*)(ws + WS_ZZ), args.in[I_BGLU]}; \
            pg8::gemm_phase<pg8::EpiGlu, pg8::PlainOrder, true, false>(lds, S, E, 2048, 2048); } while (0)
#define P5_PLE() do { pg8::PlainOrder S; S.init(M, 1024, G, bx, ws + WS_PB, 512, ws + WS_WPLE, 512, 4); \
            pg8::EpiBf16 E{(bf16_t*)(ws + WS_XBC), 1024}; \
            pg8::gemm_phase<pg8::EpiBf16, pg8::PlainOrder, true, false>(lds, S, E, 512, 512); } while (0)
        if (bx & 1) { P5_PLE(); P5_GLU(); } else { P5_GLU(); P5_PLE(); }
#undef P5_GLU
#undef P5_PLE
    } SEAM(5);
    if (IN(6)) for (int rep = 0; rep < (DBL_PHASE == 6 ? 2 : 1); ++rep) {
        if (rep) xcd_barrier(bar);
        pg8::PlainOrder S; S.init(M, 1024, G, bx, ws + WS_ZZ, 4096, ws + WS_WOUT, 4096, 32);
        pg8::EpiOut E{(const bf16_t*)(ws + WS_XN), (const float*)(ws + WS_RINV), (bf16_t*)(ws + WS_AU), (float*)(ws + WS_SS1)};
        pg8::gemm_phase<pg8::EpiOut, pg8::PlainOrder, true, false>(lds, S, E, 4096, 4096);
    } SEAM(6);
    if (IN(7)) {
        pg8::PlainOrder S; S.init(M, 1024, G, bx, ws + WS_AU, 2048, ws + WS_WGATE, 2048, 16);
        pg8::EpiGateFinal E{args.out, (const bf16_t*)(ws + WS_AU), (const bf16_t*)(ws + WS_XBC), (const float*)(ws + WS_SS1), (float*)(ws + WS_SS2), ctl + 16384, args.in[I_FINALW], lds + LDSCTL_OFF};
        pg8::gemm_phase<pg8::EpiGateFinal, pg8::PlainOrder, true, false>(lds, S, E, 2048, 2048);
    }
#undef IN
#undef SEAM
}

extern "C" void kernel_launch(void* const* d_in, const int* in_sizes, int n_in, void* d_out, int out_size, void* d_ws, size_t ws_size, hipStream_t stream) {
    static int grid = 0;
    if (grid == 0) {
        if (n_in != 25 || out_size != M * DM || ws_size < WS_END) { fprintf(stderr, "kernel_launch: unexpected shapes (n_in %d, out %d, ws %zu)\n", n_in, out_size, ws_size); grid = -1; return; }
        int dev = 0, cus = 0, per_cu = 0;
        if (hipGetDevice(&dev) != hipSuccess || hipDeviceGetAttribute(&cus, hipDeviceAttributeMultiprocessorCount, dev) != hipSuccess) { grid = -1; return; }
        if (hipFuncSetAttribute((const void*)mega_fwd, hipFuncAttributeMaxDynamicSharedMemorySize, LDS_BYTES) != hipSuccess) { fprintf(stderr, "hipFuncSetAttribute failed\n"); grid = -1; return; }
        if (hipOccupancyMaxActiveBlocksPerMultiprocessor(&per_cu, (const void*)mega_fwd, NTHR, LDS_BYTES) != hipSuccess || per_cu < 1) { fprintf(stderr, "occupancy query: %d\n", per_cu); per_cu = 1; }
        (void)hipGetLastError();
        grid = cus;
    }
    if (grid < 0) return;
    (void)hipMemsetAsync((char*)d_ws + WS_CTL, 0, CTL_ZERO_BYTES, stream);
    Args a{};
    for (int i = 0; i < 25; ++i) a.in[i] = (const float*)d_in[i];
    a.out = (float*)d_out; a.ws = (unsigned char*)d_ws;
#if MK_N_LAUNCHES == 1
    a.ph_lo = 0; a.ph_hi = N_PHASES;
    void* kargs[] = {&a};
    hipError_t e = hipLaunchCooperativeKernel((const void*)mega_fwd, dim3(grid), dim3(NTHR), kargs, LDS_BYTES, stream);
    if (e != hipSuccess) fprintf(stderr, "cooperative launch failed: %s\n", hipGetErrorString(e));
#else
    for (int ph = 0; ph < N_PHASES; ++ph) { a.ph_lo = ph; a.ph_hi = ph + 1; hipLaunchKernelGGL(mega_fwd, dim3(grid), dim3(NTHR), LDS_BYTES, stream, a); }
#endif
}
```

```cpp
#include <hip/hip_runtime.h>
#include <cstdio>
#include <cstdint>

#ifndef MK_N_LAUNCHES
#define MK_N_LAUNCHES 1
#endif

#define LAS __attribute__((address_space(3)))
#define GAS __attribute__((address_space(1)))
typedef unsigned short bf16_t;
typedef short bf16x8 __attribute__((ext_vector_type(8)));
typedef float f32x4 __attribute__((ext_vector_type(4)));
typedef float f32x2 __attribute__((ext_vector_type(2)));
typedef unsigned u32x4 __attribute__((ext_vector_type(4)));
typedef unsigned u32x2 __attribute__((ext_vector_type(2)));

constexpr int NB = 4, SEQ = 8192, DM = 1024, M = NB * SEQ, NPROJ = 5136, PLE = 256;
constexpr int NCH = SEQ / 64;
constexpr int SCH = 8, SCH_LG = 3;
constexpr int NSC = SEQ / (64 * SCH);
constexpr int NSC_LG = 4;
constexpr size_t YPRE_OFF = 40 * (1u << 20);
constexpr int AUW = 1152;
constexpr float EPS = 1e-6f;
constexpr int NWAVES = 8, NTHR = 512;

constexpr size_t MiB = 1u << 20;
constexpr size_t WS_CTL   = 0;
constexpr size_t CTL_ZERO_BYTES = 96 * 1024;
constexpr size_t WS_WIN   = 1 * MiB;
constexpr size_t WS_WGLU  = 11 * MiB;
constexpr size_t WS_WOUT  = 13 * MiB;
constexpr size_t WS_WGATE = 17 * MiB;
constexpr size_t WS_WPLE  = 19 * MiB;
constexpr size_t WS_AB64  = 19 * MiB + 512 * 1024;
constexpr size_t WS_CD    = 19 * MiB + 576 * 1024;
constexpr size_t WS_SS1   = 20 * MiB;
constexpr size_t WS_SS2   = 22 * MiB;
constexpr size_t WS_RINV  = 23 * MiB;
constexpr size_t WS_DT    = 24 * MiB;
constexpr size_t WS_KR    = 26 * MiB;
constexpr size_t WS_Q     = 30 * MiB;
constexpr size_t WS_P     = 46 * MiB;
constexpr size_t WS_PB    = 62 * MiB;
constexpr size_t WS_S5S   = 78 * MiB;
constexpr size_t WS_XN    = 94 * MiB;
constexpr size_t WS_AU    = 158 * MiB;
constexpr size_t WS_ZZ    = 230 * MiB;
constexpr size_t WS_XBC   = 358 * MiB;
constexpr size_t WS_S5S2  = 486 * MiB;
constexpr size_t WS_END   = 502 * MiB;

constexpr int RING_BYTES = 131072, LDS_BYTES = 163840, LDSCTL_OFF = LDS_BYTES - 8192;

__device__ __forceinline__ float bf2f(unsigned short b) { return __uint_as_float((unsigned)b << 16); }
__device__ __forceinline__ float bflo(unsigned w) { return __uint_as_float(w << 16); }
__device__ __forceinline__ float bfhi(unsigned w) { return __uint_as_float(w & 0xffff0000u); }
__device__ __forceinline__ unsigned cvt_pk_bf16(float lo, float hi) { unsigned r; asm volatile("v_cvt_pk_bf16_f32 %0, %1, %2" : "=v"(r) : "v"(lo), "v"(hi)); return r; }
__device__ __forceinline__ unsigned short f2bf(float f) { return (unsigned short)(cvt_pk_bf16(f, 0.f) & 0xffffu); }
__device__ __forceinline__ float sigmoidf_(float x) { return __builtin_amdgcn_rcpf(1.f + __expf(-x)); }
__device__ __forceinline__ float siluf_(float x) { return x * sigmoidf_(x); }
__device__ __forceinline__ float gelu_tanh(float x) { const float u = 0.7978845608028654f * (x + 0.044715f * x * x * x); const float e = __expf(2.f * u); return x * (1.f - __builtin_amdgcn_rcpf(e + 1.f)); }
__device__ __forceinline__ float softplusf_(float x) { return x > 20.f ? x : log1pf(expf(x)); }
__device__ __forceinline__ float wave_sum(float v) {
#pragma unroll
    for (int o = 1; o < 64; o <<= 1) v += __shfl_xor(v, o);
    return v;
}

#define XB_TMO      128
#define XB_XCNT(j)  (256  + 64 * (j))
#define XB_XSUB(j)  (1280 + 64 * (j))
#define XB_XGEN(j)  (2304 + 64 * (j))
#define XB_TOP      3328
#define XB_TOPGEN   3392
#define XCD_BAR_WORDS 3456
#define XB_SPIN_CAP (1u << 18)
__device__ __forceinline__ unsigned xb_ld(unsigned* p)              { return __hip_atomic_load(p, __ATOMIC_RELAXED, __HIP_MEMORY_SCOPE_AGENT); }
__device__ __forceinline__ unsigned xb_add(unsigned* p, unsigned v) { return __hip_atomic_fetch_add(p, v, __ATOMIC_RELAXED, __HIP_MEMORY_SCOPE_AGENT); }
__device__ __forceinline__ unsigned xb_xcc_id() { return (unsigned)__builtin_amdgcn_s_getreg((3 << 11) | 20) & 0xFu; }
#define XB_SPIN(cond, bar) do { unsigned _sp = 0; while (cond) { __builtin_amdgcn_s_sleep(1); \
    if ((++_sp & 255u) == 0u) { if (xb_ld(&(bar)[XB_TMO])) break; if (_sp > XB_SPIN_CAP) { atomicAdd(&(bar)[XB_TMO], 1u); break; } } } } while (0)
struct XcdBarrier { unsigned* bar; unsigned x; volatile LAS unsigned* st; };
__device__ __forceinline__ XcdBarrier xcd_barrier_post(unsigned* bar, volatile LAS unsigned* st) {
    XcdBarrier b; b.bar = bar; b.x = xb_xcc_id(); b.st = st;
    if (threadIdx.x == 0) (void)xb_add(&bar[XB_XCNT(b.x)], 1u);
    return b;
}
__device__ __forceinline__ void xcd_barrier_complete(unsigned* bar, unsigned x, unsigned& nloc, unsigned& nx) {
    const unsigned G = gridDim.x * gridDim.y * gridDim.z;
    unsigned sum, cnt, mine, sp = 0u;
    for (;;) {
        sum = 0u; cnt = 0u; mine = 0u;
#pragma unroll
        for (unsigned j = 0; j < 16; ++j) { const unsigned c = xb_ld(&bar[XB_XCNT(j)]); sum += c; cnt += (c > 0u) ? 1u : 0u; mine = (j == x) ? c : mine; }
        if (sum == G) break;
        __builtin_amdgcn_s_sleep(1);
        if ((++sp & 255u) == 0u) { if (xb_ld(&bar[XB_TMO])) break; if (sp > XB_SPIN_CAP) { atomicAdd(&bar[XB_TMO], 1u); break; } }
    }
    nloc = mine > 0u ? mine : 1u; nx = cnt > 0u ? cnt : 1u;
}
__device__ __forceinline__ void xcd_barrier(const XcdBarrier& b) {
    asm volatile("s_waitcnt vmcnt(0)" ::: "memory");
    __syncthreads();
    if (threadIdx.x == 0) {
        unsigned* bar = b.bar;
        __builtin_amdgcn_s_waitcnt(0);
        unsigned nloc = b.st[0], nx = b.st[1];
        if (nloc == 0u) { xcd_barrier_complete(bar, b.x, nloc, nx); b.st[0] = nloc; b.st[1] = nx; }
        const unsigned old = xb_add(&bar[XB_XSUB(b.x)], 1u);
        const unsigned gen = old / nloc;
        if (old + 1u == (gen + 1u) * nloc) {
            __builtin_amdgcn_fence(__ATOMIC_RELEASE, "agent");
            asm volatile("s_waitcnt vmcnt(0)" ::: "memory");
            const unsigned og = xb_add(&bar[XB_TOP], 1u);
            const unsigned target = (og / nx + 1u) * nx;
            if (og + 1u != target) XB_SPIN(xb_ld(&bar[XB_TOP]) < target, bar);
            __builtin_amdgcn_fence(__ATOMIC_ACQUIRE, "agent");
            xb_add(&bar[XB_XGEN(b.x)], 1u);
            asm volatile("s_waitcnt vmcnt(0)" ::: "memory");
        } else {
            XB_SPIN(xb_ld(&bar[XB_XGEN(b.x)]) == gen, bar);
            __builtin_amdgcn_fence(__ATOMIC_ACQUIRE, "agent");
            asm volatile("s_waitcnt vmcnt(0)" ::: "memory");
        }
    }
    __syncthreads();
}

namespace pg8 {
constexpr int BM = 256, BK = 64, HALF = 128, HTB = HALF * BK * 2, NXCD = 8, WGM = 8;
__host__ __device__ __forceinline__ int lds_byte(int r, int c) { const int st = (r >> 4) * 2 + (c >> 5), rr = r & 15, cc = c & 31, ob = rr * 64 + cc * 2; return st * 1024 + (ob ^ (((ob >> 9) & 1) << 5)); }
__host__ __device__ __forceinline__ void stage_rc(int b, int& R, int& C) { const int st = b / 1024, sb = b % 1024, swz = sb ^ (((sb >> 9) & 1) << 5); R = (st >> 1) * 16 + swz / 64; C = (st & 1) * 32 + (swz % 64) / 2; }
__host__ __device__ __forceinline__ int perm32(int rho) { const int n = rho >> 4, i = rho & 15; return 8 * (i >> 2) + 4 * n + (i & 3); }

struct Unit { int pm, pn, g, nt; const char* a; const char* b; const char* bt; };

struct PlainOrder {
    int nM, nN, nwg, G, c, nt; const char* A; const char* B; long tsA, tsB;
    __device__ void init(int M_, int N_, int G_, int c_, const void* A_, long lda_b, const void* B_, long ldb_b, int nt_) {
        nM = M_ / BM; nN = N_ / BM; nwg = nM * nN; G = G_; c = c_; nt = nt_; A = (const char*)A_; B = (const char*)B_; tsA = 256 * lda_b; tsB = 256 * ldb_b; }
    __device__ bool next(int i, Unit& u) const {
        const long Lx = (long)i * G + c; if (Lx >= nwg) return false;
        int wgid = (int)Lx; { const int q = nwg / NXCD, r = nwg % NXCD, xcd = wgid % NXCD, off = wgid / NXCD; wgid = (xcd < r ? xcd * (q + 1) : r * (q + 1) + (xcd - r) * q) + off; }
        const int nig = WGM * nN, gid = wgid / nig, fm = gid * WGM, gsz = (nM - fm) < WGM ? (nM - fm) : WGM;
        u.pm = fm + ((wgid % nig) % gsz); u.pn = (wgid % nig) / gsz; u.g = 0; u.nt = nt;
        u.a = A + (long)u.pm * tsA; u.b = B + (long)u.pn * tsB; u.bt = u.b; return true;
    }
};

template <class Epi, class Sched, bool ALIGN_EPI, bool TOEP>
__device__ __forceinline__ void gemm_phase(LAS unsigned char* lds, const Sched& S, const Epi& E, const int lda_b, const int ldb_b) {
    int tid = threadIdx.x; asm volatile("" : "+v"(tid));
    const int wid = __builtin_amdgcn_readfirstlane(tid >> 6), lane = tid & 63, wr = wid >> 2, wc = wid & 3, fr = lane & 15, fq = lane >> 4;
    unsigned voffA[2], voffB[2], voffT[2];
#pragma unroll
    for (int i = 0; i < 2; ++i) { int R, C; stage_rc(tid * 16 + i * 8192, R, C); const int Rb = Epi::PERM ? ((R & ~31) + perm32(R & 31)) : R;
        voffA[i] = (unsigned)(R * lda_b + C * 2); voffB[i] = (unsigned)(Rb * ldb_b + C * 2);
        voffT[i] = (unsigned)(((Rb & 15) * 2048 + (7 - (Rb >> 4)) * 16 + C) * 2); }
    const long kstep = BK * 2;
    const long hsA = (long)HALF * lda_b, hsBq = (long)HALF * ldb_b, hsBt = -256;
    const unsigned ldsw = (unsigned)wid * 1024u;
    const int aoff = lds_byte(wr * 64 + fr, fq * 8), boff = lds_byte(wc * 32 + fr, fq * 8);
#define PG8_SA(b, h) (((b) * 2 + (h)) * HTB)
#define PG8_SB(b, h) ((4 + (b) * 2 + (h)) * HTB)
#define PG8_STAGE2(bufoff, gbase, v0, v1) do { \
        __builtin_amdgcn_global_load_lds((const unsigned*)((const char*)(gbase) + (v0)), (LAS unsigned*)(lds + (bufoff) + ldsw), 16, 0, 0); \
        __builtin_amdgcn_global_load_lds((const unsigned*)((const char*)(gbase) + (v1)), (LAS unsigned*)(lds + (bufoff) + ldsw + 8192), 16, 0, 0); } while (0)
#define PG8_STAGEA(bufoff, gbase) PG8_STAGE2(bufoff, gbase, voffA[0], voffA[1])
#define PG8_LDA(dst, b, h) do { _Pragma("unroll") for (int m = 0; m < 4; ++m) _Pragma("unroll") for (int k = 0; k < 2; ++k) dst[m][k] = *(const LAS bf16x8*)(lds + PG8_SA(b, h) + aoff + m * 2048 + k * 1024); } while (0)
#define PG8_LDB(dst, b, h) do { _Pragma("unroll") for (int n = 0; n < 2; ++n) _Pragma("unroll") for (int k = 0; k < 2; ++k) dst[n][k] = *(const LAS bf16x8*)(lds + PG8_SB(b, h) + boff + n * 2048 + k * 1024); } while (0)
#define PG8_MMA(ai, bj, At, Bt) do { __builtin_amdgcn_s_setprio(1); _Pragma("unroll") for (int m = 0; m < 4; ++m) _Pragma("unroll") for (int n = 0; n < 2; ++n) _Pragma("unroll") for (int k = 0; k < 2; ++k) \
        acc[ai][bj][m][n] = __builtin_amdgcn_mfma_f32_16x16x32_bf16(Bt[n][k], At[m][k], acc[ai][bj][m][n], 0, 0, 0); __builtin_amdgcn_s_setprio(0); } while (0)
#define PG8_WAIT_V(n) asm volatile("s_waitcnt vmcnt(" #n ")" ::: "memory")
#define PG8_WAIT_L(n) asm volatile("s_waitcnt lgkmcnt(" #n ")" ::: "memory")
#define PG8_BAR __builtin_amdgcn_s_barrier()
#define PG8_SCHED __builtin_amdgcn_sched_barrier(0)
    Unit cur, nxt; int ui = 0;
    if (!S.next(0, cur)) return;
    f32x4 acc[2][2][4][2];
#pragma unroll
    for (int a = 0; a < 2; ++a)
#pragma unroll
        for (int b = 0; b < 2; ++b)
#pragma unroll
            for (int m = 0; m < 4; ++m)
#pragma unroll
                for (int n = 0; n < 2; ++n) acc[a][b][m][n] = (f32x4){0.f, 0.f, 0.f, 0.f};
    bf16x8 At[4][2], B0[2][2], B1[2][2];
    const char* cA = cur.a; const char* cB = cur.b; const char* cBt = cur.bt;
    PG8_STAGE2(PG8_SB(0, 0), cB, voffB[0], voffB[1]); PG8_STAGE2(PG8_SB(0, 1), cB + hsBq, voffB[0], voffB[1]); PG8_STAGEA(PG8_SA(0, 0), cA); PG8_STAGEA(PG8_SA(0, 1), cA + hsA);
    if (wr == 1) PG8_BAR;
    PG8_WAIT_V(2); PG8_BAR;
    PG8_STAGE2(PG8_SB(1, 0), cB + kstep, voffB[0], voffB[1]); PG8_STAGEA(PG8_SA(1, 0), cA + kstep); PG8_STAGE2(PG8_SB(1, 1), cB + hsBq + kstep, voffB[0], voffB[1]);
    PG8_WAIT_V(6); PG8_BAR;
    for (;;) {
        const bool has_next = S.next(ui + 1, nxt);
        const char* nA = has_next ? nxt.a : cA; const char* nB = has_next ? nxt.b : cB;
        const int nt = cur.nt;
        for (int t = 0; t < nt; t += 2) {
            const bool last = (t == nt - 2);
            const char* a1 = cA + (long)(t + 1) * kstep;
            const char* a2 = last ? nA : cA + (long)(t + 2) * kstep;
            const char* a3 = a2 + kstep;
            const char* b2; long hsB; unsigned vb0, vb1;
            if (TOEP) {
                if (last) { b2 = nB; hsB = hsBq; vb0 = voffB[0]; vb1 = voffB[1]; }
                else { b2 = cBt + (long)t * kstep; hsB = hsBt; vb0 = voffT[0]; vb1 = voffT[1]; }
            } else { b2 = last ? nB : cB + (long)(t + 2) * kstep; hsB = hsBq; vb0 = voffB[0]; vb1 = voffB[1]; }
            const char* b3 = b2 + kstep;
            PG8_LDB(B0, 0, 0); PG8_LDB(B1, 0, 1); PG8_SCHED; PG8_LDA(At, 0, 0); PG8_STAGEA(PG8_SA(1, 1), a1 + hsA);
            PG8_WAIT_V(8); PG8_WAIT_L(0); PG8_BAR; PG8_MMA(0, 0, At, B0); PG8_MMA(0, 1, At, B1); PG8_BAR; PG8_SCHED;
            PG8_LDA(At, 0, 1); PG8_STAGE2(PG8_SB(0, 0), b2, vb0, vb1); PG8_STAGE2(PG8_SB(0, 1), b2 + hsB, vb0, vb1); PG8_STAGEA(PG8_SA(0, 0), a2);
            PG8_WAIT_V(8); PG8_WAIT_L(0); PG8_BAR; PG8_MMA(1, 0, At, B0); PG8_MMA(1, 1, At, B1); PG8_BAR; PG8_SCHED;
            PG8_LDB(B0, 1, 0); PG8_LDB(B1, 1, 1); PG8_SCHED; PG8_LDA(At, 1, 0); PG8_STAGEA(PG8_SA(0, 1), a2 + hsA);
            PG8_WAIT_V(8); PG8_WAIT_L(0); PG8_BAR; PG8_MMA(0, 0, At, B0); PG8_MMA(0, 1, At, B1); PG8_BAR; PG8_SCHED;
            PG8_LDA(At, 1, 1); PG8_STAGE2(PG8_SB(1, 0), b3, vb0, vb1); PG8_STAGE2(PG8_SB(1, 1), b3 + hsB, vb0, vb1); PG8_STAGEA(PG8_SA(1, 0), a3);
            PG8_WAIT_V(8); PG8_WAIT_L(0); PG8_BAR; PG8_MMA(1, 0, At, B0); PG8_MMA(1, 1, At, B1); PG8_BAR; PG8_SCHED;
        }
        if constexpr (ALIGN_EPI) { if (wr == 0) PG8_BAR; }
        E(acc, cur, wr, wc, fr, fq);
        if (!has_next) break;
#pragma unroll
        for (int a = 0; a < 2; ++a)
#pragma unroll
            for (int b = 0; b < 2; ++b)
#pragma unroll
                for (int m = 0; m < 4; ++m)
#pragma unroll
                    for (int n = 0; n < 2; ++n) acc[a][b][m][n] = (f32x4){0.f, 0.f, 0.f, 0.f};
        cur = nxt; cA = nA; cB = nB; cBt = nxt.bt; ++ui;
        if constexpr (ALIGN_EPI) { if (wr == 1) PG8_BAR; }
    }
    PG8_WAIT_V(0);
    if constexpr (!ALIGN_EPI) { if (wr == 0) PG8_BAR; }
    PG8_BAR;
#undef PG8_SA
#undef PG8_SB
#undef PG8_STAGE2
#undef PG8_STAGEA
#undef PG8_LDA
#undef PG8_LDB
#undef PG8_MMA
#undef PG8_WAIT_V
#undef PG8_WAIT_L
#undef PG8_BAR
#undef PG8_SCHED
}

__device__ __forceinline__ u32x4 pack8(const f32x4 v0, const f32x4 v1) { u32x4 w; w.x = cvt_pk_bf16(v0[0], v0[1]); w.y = cvt_pk_bf16(v0[2], v0[3]); w.z = cvt_pk_bf16(v1[0], v1[1]); w.w = cvt_pk_bf16(v1[2], v1[3]); return w; }
__device__ __forceinline__ void unpack8(const u32x4 w, f32x4& a, f32x4& b) { a = (f32x4){bflo(w.x), bfhi(w.x), bflo(w.y), bfhi(w.y)}; b = (f32x4){bflo(w.z), bfhi(w.z), bflo(w.w), bfhi(w.w)}; }

struct EpiInProj {
    static constexpr bool PERM = true;
    bf16_t* AU; bf16_t* ZZ; bf16_t* XBC;
    __device__ __forceinline__ void operator()(const f32x4 (&acc)[2][2][4][2], const Unit& u, int wr, int wc, int fr, int fq) const {
        const int row0 = u.pm * BM + wr * 64 + fr, colt = u.pn * BM + wc * 32 + 8 * fq;
        const bool zs = u.pn >= 8 && u.pn < 12;
#pragma unroll
        for (int ai = 0; ai < 2; ++ai)
#pragma unroll
            for (int m = 0; m < 4; ++m) { const int row = row0 + ai * HALF + m * 16;
#pragma unroll
                for (int bj = 0; bj < 2; ++bj) { const int col = colt + bj * HALF; f32x4 a0 = acc[ai][bj][m][0], a1 = acc[ai][bj][m][1];
                    if (zs) {
#pragma unroll
                        for (int e = 0; e < 4; ++e) { a0[e] = siluf_(a0[e]); a1[e] = siluf_(a1[e]); } }
                    const u32x4 w = pack8(a0, a1);
                    bf16_t* dst;
                    if (u.pn < 4) dst = AU + ((size_t)((col >> 4) * 512 + (row >> 6)) * AUW + 128 + (row & 63) * 16 + (col & 15));
                    else if (u.pn < 8) dst = ZZ + (size_t)(u.pm * BM + 2 * ((((ai * 4 + m) * 2 + bj) * 8) + wr * 4 + wc) + (fq >> 1)) * 2048 + (u.pn - 4) * BM + ((fr + 16 * fq) & 31) * 8;
                    else if (u.pn < 12) dst = ZZ + (size_t)row * 2048 + (col - 1024);
                    else dst = XBC + (size_t)row * 2048 + (col - 3072);
                    *(u32x4*)dst = w; } }
    }
};
struct EpiBf16 {
    static constexpr bool PERM = true;
    bf16_t* O; int ldc;
    __device__ __forceinline__ void operator()(const f32x4 (&acc)[2][2][4][2], const Unit& u, int wr, int wc, int fr, int fq) const {
        bf16_t* tb = O + (size_t)(u.pm * 4 + u.pn) * 65536 + ((wr * 4 + wc) * 64 + fr + 16 * fq) * 8;
#pragma unroll
        for (int ai = 0; ai < 2; ++ai)
#pragma unroll
            for (int m = 0; m < 4; ++m)
#pragma unroll
                for (int bj = 0; bj < 2; ++bj) *(u32x4*)(tb + ((ai * 4 + m) * 2 + bj) * 4096) = pack8(acc[ai][bj][m][0], acc[ai][bj][m][1]);
    }
};
struct EpiGlu {
    static constexpr bool PERM = true;
    const bf16_t* Y; bf16_t* ZZ; const float* bias;
    __device__ __forceinline__ void operator()(const f32x4 (&acc)[2][2][4][2], const Unit& u, int wr, int wc, int fr, int fq) const {
        asm volatile("" : "+v"(fr), "+v"(fq));
        const int row0 = u.pm * BM + wr * 64 + fr, col0 = u.pn * BM + wc * 32 + 8 * fq;
        f32x4 bv[2][2];
#pragma unroll
        for (int bj = 0; bj < 2; ++bj) { bv[bj][0] = *(const f32x4*)(bias + col0 + bj * HALF); bv[bj][1] = *(const f32x4*)(bias + col0 + bj * HALF + 4); }
#pragma unroll
        for (int ai = 0; ai < 2; ++ai) {
            u32x4 yw[4][2], zw[4][2];
#pragma unroll
            for (int m = 0; m < 4; ++m)
#pragma unroll
                for (int bj = 0; bj < 2; ++bj) { const size_t row = (size_t)(row0 + ai * HALF + m * 16); const int col = col0 + bj * HALF;
                    yw[m][bj] = *(const u32x4*)(Y + row * 1024 + col);
                    zw[m][bj] = *(const u32x4*)(ZZ + (size_t)(u.pm * BM + 2 * ((((ai * 4 + m) * 2 + bj) * 8) + wr * 4 + wc) + (fq >> 1)) * 2048 + u.pn * BM + ((fr + 16 * fq) & 31) * 8); }
            asm volatile("s_waitcnt vmcnt(0)" ::: "memory"); __builtin_amdgcn_s_barrier(); asm volatile("" ::: "memory");
#pragma unroll
            for (int m = 0; m < 4; ++m)
#pragma unroll
                for (int bj = 0; bj < 2; ++bj) { const size_t row = (size_t)(row0 + ai * HALF + m * 16); const int col = col0 + bj * HALF;
                    f32x4 y0, y1, z0, z1; unpack8(yw[m][bj], y0, y1); unpack8(zw[m][bj], z0, z1);
                    const f32x4 a0 = acc[ai][bj][m][0] + bv[bj][0], a1 = acc[ai][bj][m][1] + bv[bj][1]; f32x4 o0, o1;
#pragma unroll
                    for (int e = 0; e < 4; ++e) { o0[e] = y0[e] * sigmoidf_(a0[e]) * siluf_(z0[e]); o1[e] = y1[e] * sigmoidf_(a1[e]) * siluf_(z1[e]); }
                    *(u32x4*)(ZZ + row * 2048 + col) = pack8(o0, o1); }
            asm volatile("" ::: "memory");
        }
    }
};
struct EpiOut {
    static constexpr bool PERM = true;
    const bf16_t* XN; const float* RINV; bf16_t* Hb; float* SS;
    __device__ __forceinline__ void operator()(const f32x4 (&acc)[2][2][4][2], const Unit& u, int wr, int wc, int fr, int fq) const {
        const int row0 = u.pm * BM + wr * 64 + fr, col0 = u.pn * BM + wc * 32 + 8 * fq;
#pragma unroll
        for (int ai = 0; ai < 2; ++ai) {
            u32x4 xw[4][2]; float ri[4];
#pragma unroll
            for (int m = 0; m < 4; ++m) { const size_t row = (size_t)(row0 + ai * HALF + m * 16); ri[m] = RINV[row];
#pragma unroll
                for (int bj = 0; bj < 2; ++bj) xw[m][bj] = *(const u32x4*)(XN + row * 1024 + col0 + bj * HALF); }
#pragma unroll
            for (int m = 0; m < 4; ++m) { const size_t row = (size_t)(row0 + ai * HALF + m * 16); float ss = 0.f;
#pragma unroll
                for (int bj = 0; bj < 2; ++bj) { const int col = col0 + bj * HALF;
                    f32x4 x0, x1; unpack8(xw[m][bj], x0, x1);
                    const f32x4 h0 = acc[ai][bj][m][0] + x0 * ri[m], h1 = acc[ai][bj][m][1] + x1 * ri[m];
                    *(u32x4*)(Hb + row * 1024 + col) = pack8(h0, h1);
                    ss += ((h0[0] * h0[0] + h0[1] * h0[1]) + (h0[2] * h0[2] + h0[3] * h0[3])) + ((h1[0] * h1[0] + h1[1] * h1[1]) + (h1[2] * h1[2] + h1[3] * h1[3])); }
                ss += __shfl_xor(ss, 16); ss += __shfl_xor(ss, 32);
                if (fq == 0) SS[row * 16 + u.pn * 4 + wc] = ss; }
            asm volatile("" ::: "memory");
        }
    }
};
struct EpiGate {
    static constexpr bool PERM = false;
    float* H; const bf16_t* Hb; const bf16_t* PL; const float* SS1; float* SS2;
    __device__ __forceinline__ void operator()(const f32x4 (&acc)[2][2][4][2], const Unit& u, int wr, int wc, int fr, int fq) const {
        const int row0 = u.pm * BM + wr * 64 + fr, col0 = u.pn * BM + wc * 32 + 4 * fq;
#pragma unroll
        for (int ai = 0; ai < 2; ++ai)
#pragma unroll
            for (int m = 0; m < 4; ++m) { const size_t row = (size_t)(row0 + ai * HALF + m * 16);
                const f32x4 s0 = *(const f32x4*)(SS1 + row * 16), s1 = *(const f32x4*)(SS1 + row * 16 + 4), s2 = *(const f32x4*)(SS1 + row * 16 + 8), s3 = *(const f32x4*)(SS1 + row * 16 + 12);
                const f32x4 st = (s0 + s1) + (s2 + s3);
                const float r = rsqrtf(((st[0] + st[1]) + (st[2] + st[3])) * (1.f / 1024.f) + EPS);
                float ss = 0.f;
#pragma unroll
                for (int bj = 0; bj < 2; ++bj)
#pragma unroll
                    for (int n = 0; n < 2; ++n) { const int col = col0 + bj * HALF + n * 16;
                        const u32x2 hw = *(const u32x2*)(Hb + row * 1024 + col); const f32x4 h = (f32x4){bflo(hw.x), bfhi(hw.x), bflo(hw.y), bfhi(hw.y)}; const u32x2 pw = *(const u32x2*)(PL + row * 1024 + col);
                        const f32x4 pl = (f32x4){bflo(pw.x), bfhi(pw.x), bflo(pw.y), bfhi(pw.y)}; const f32x4 a = acc[ai][bj][m][n] * r; f32x4 o;
#pragma unroll
                        for (int e = 0; e < 4; ++e) o[e] = h[e] + pl[e] * sigmoidf_(a[e]);
                        *(f32x4*)(H + row * 1024 + col) = o;
                        ss += (o[0] * o[0] + o[1] * o[1]) + (o[2] * o[2] + o[3] * o[3]); }
                ss += __shfl_xor(ss, 16); ss += __shfl_xor(ss, 32);
                if (fq == 0) SS2[row * 16 + u.pn * 4 + wc] = ss;
                if (m & 1) asm volatile("" ::: "memory"); }
    }
};

struct EpiGateFinal {
    static constexpr bool PERM = true;
    float* OUT; const bf16_t* Hb; const bf16_t* PL; const float* SS1; float* XS; unsigned* cnt; const float* fw; LAS unsigned char* lx;
    __device__ __forceinline__ void operator()(f32x4 (&acc)[2][2][4][2], const Unit& u, int wr, int wc, int fr, int fq) const {
        const int tid = threadIdx.x, lane = tid & 63, wid = __builtin_amdgcn_readfirstlane(tid >> 6);
        LAS float* P = (LAS float*)(lx + 1024);
        LAS float* S = (LAS float*)(lx + 1024 + 4096);
        const int row0 = u.pm * BM + wr * 64 + fr, col0 = u.pn * BM + wc * 32 + 8 * fq;
#pragma unroll
        for (int ai = 0; ai < 2; ++ai) {
            f32x4 sq[4]; u32x4 hw[4][2], pw[4][2];
#pragma unroll
            for (int m = 0; m < 4; ++m) { const size_t row = (size_t)(row0 + ai * HALF + m * 16); sq[m] = *(const f32x4*)(SS1 + row * 16 + 4 * fq);
#pragma unroll
                for (int bj = 0; bj < 2; ++bj) { hw[m][bj] = *(const u32x4*)(Hb + row * 1024 + col0 + bj * HALF);
                    pw[m][bj] = *(const u32x4*)(PL + (size_t)(u.pm * 4 + u.pn) * 65536 + (size_t)((((ai * 4 + m) * 2 + bj) * 8 + wid) * 64 + lane) * 8); } }
#pragma unroll
            for (int m = 0; m < 4; ++m) {
                float st = (sq[m][0] + sq[m][1]) + (sq[m][2] + sq[m][3]); st += __shfl_xor(st, 16); st += __shfl_xor(st, 32);
                const float r = rsqrtf(st * (1.f / 1024.f) + EPS);
                float ss = 0.f;
#pragma unroll
                for (int bj = 0; bj < 2; ++bj) {
                    f32x4 hh[2], pl[2]; unpack8(hw[m][bj], hh[0], hh[1]); unpack8(pw[m][bj], pl[0], pl[1]);
#pragma unroll
                    for (int n = 0; n < 2; ++n) { const f32x4 a = acc[ai][bj][m][n] * r; f32x4 o;
#pragma unroll
                        for (int e = 0; e < 4; ++e) o[e] = hh[n][e] + pl[n][e] * sigmoidf_(a[e]);
                        acc[ai][bj][m][n] = o;
                        ss += (o[0] * o[0] + o[1] * o[1]) + (o[2] * o[2] + o[3] * o[3]); } }
                ss += __shfl_xor(ss, 16); ss += __shfl_xor(ss, 32);
                if (fq == 0) P[(ai * HALF + wr * 64 + m * 16 + fr) * 4 + wc] = ss; }
            asm volatile("" ::: "memory");
        }
        f32x4 wv[2][2];
#pragma unroll
        for (int bj = 0; bj < 2; ++bj)
#pragma unroll
            for (int n = 0; n < 2; ++n) wv[bj][n] = *(const f32x4*)(fw + col0 + bj * HALF + n * 4);
        asm volatile("s_waitcnt lgkmcnt(0)" ::: "memory"); __builtin_amdgcn_s_barrier(); asm volatile("" ::: "memory");
        if (tid < 256) { const f32x4 p4 = *(const LAS f32x4*)(P + tid * 4);
            __hip_atomic_store(XS + (size_t)(u.pm * BM + tid) * 4 + u.pn, (p4[0] + p4[1]) + (p4[2] + p4[3]), __ATOMIC_RELAXED, __HIP_MEMORY_SCOPE_AGENT); }
        asm volatile("s_waitcnt vmcnt(0)" ::: "memory");
        if (tid < 256 && lane == 0) __hip_atomic_fetch_add(cnt + 64 * u.pm, 1u, __ATOMIC_RELAXED, __HIP_MEMORY_SCOPE_AGENT);
        if (wid == 0) {
            unsigned sp = 0;
            while ((unsigned)__builtin_amdgcn_readfirstlane(__hip_atomic_load(cnt + 64 * u.pm, __ATOMIC_RELAXED, __HIP_MEMORY_SCOPE_AGENT)) < 16u) { __builtin_amdgcn_s_sleep(2); if (++sp > (1u << 22)) break; }
            __builtin_amdgcn_fence(__ATOMIC_ACQUIRE, "agent");
        }
        asm volatile("s_waitcnt vmcnt(0) lgkmcnt(0)" ::: "memory"); __builtin_amdgcn_s_barrier(); asm volatile("" ::: "memory");
        if (tid < 256) { const float* xs = XS + (size_t)(u.pm * BM + tid) * 4; float t = 0.f;
#pragma unroll
            for (int k = 0; k < 4; ++k) t += __hip_atomic_load(xs + k, __ATOMIC_RELAXED, __HIP_MEMORY_SCOPE_AGENT);
            S[tid] = rsqrtf(t * (1.f / 1024.f) + EPS); }
        asm volatile("s_waitcnt vmcnt(0) lgkmcnt(0)" ::: "memory"); __builtin_amdgcn_s_barrier(); asm volatile("" ::: "memory");
#pragma unroll
        for (int ai = 0; ai < 2; ++ai)
#pragma unroll
            for (int m = 0; m < 4; ++m) { const int rl = ai * HALF + wr * 64 + m * 16 + fr; const float r2 = S[rl]; const size_t row = (size_t)(u.pm * BM + rl);
#pragma unroll
                for (int bj = 0; bj < 2; ++bj)
#pragma unroll
                    for (int n = 0; n < 2; ++n) *(f32x4*)(OUT + row * 1024 + col0 + bj * HALF + n * 4) = acc[ai][bj][m][n] * r2 * wv[bj][n]; }
    }
};

struct S5SOrder {
    int c; const char* AU; const char* P;
    __device__ bool next(int i, Unit& u) const {
        if (i != 0 || c >= 256) return false;
        const int g = c >> 2, pm = (c >> 1) & 1, kh = c & 1;
        u.pm = pm; u.pn = kh; u.g = g; u.nt = 8;
        u.a = AU + ((size_t)(g * 512 + pm * 256) * AUW + 128 + kh * 512) * 2; u.b = P + ((size_t)g * 128 * 1024 + kh * 512) * 2; u.bt = u.b; return true;
    }
};
struct EpiS5S {
    static constexpr bool PERM = false;
    float* S0; long half_stride;
    __device__ __forceinline__ void operator()(const f32x4 (&acc)[2][2][4][2], const Unit& u, int wr, int wc, int fr, int fq) const {
        float* S = S0 + (long)u.pn * half_stride + (size_t)(u.g * 512 + u.pm * 256) * 128;
        const int row0 = wr * 64 + fr, col0 = wc * 32 + 4 * fq;
#pragma unroll
        for (int ai = 0; ai < 2; ++ai)
#pragma unroll
            for (int m = 0; m < 4; ++m)
#pragma unroll
                for (int n = 0; n < 2; ++n) *(f32x4*)(S + (size_t)(row0 + ai * HALF + m * 16) * 128 + col0 + n * 16) = acc[ai][0][m][n];
    }
};
struct S5YOrder {
    int c; const char* AU; const char* Q; const char* KR;
    __device__ bool next(int i, Unit& u) const {
        if (i > 1 || c >= 256) return false;
        const int x = c & 7, k = c >> 3, lt = k >> 2;
        const int g = (x + 8 * (lt >> 2)) * 4 + (k & 3), pm = lt & 1, pair = (lt >> 1) & 1;
        const int pn = pair ? (i == 0 ? 1 : 2) : (i == 0 ? 0 : 3);
        u.pm = pm; u.pn = pn; u.g = g; u.nt = 4 * pn + 6;
        u.a = AU + (size_t)(g * 512 + pm * 256) * AUW * 2;
        u.b = Q + ((size_t)g * 1024 + pn * 256) * 128 * 2;
        u.bt = KR + (size_t)g * 65536 + (896 - pn * 256) * 2;
        return true;
    }
};
struct EpiS5Y {
    static constexpr bool PERM = true;
    bf16_t* Y;
    __device__ __forceinline__ void operator()(const f32x4 (&acc)[2][2][4][2], const Unit& u, int wr, int wc, int fr, int fq) const {
        const int row0 = u.pm * BM + wr * 64 + fr, col0 = u.pn * BM + wc * 32 + 8 * fq;
        const int h0 = col0 & 15;
#pragma unroll
        for (int ai = 0; ai < 2; ++ai)
#pragma unroll
            for (int m = 0; m < 4; ++m) { const int bc = row0 + ai * HALF + m * 16;
#pragma unroll
                for (int bj = 0; bj < 2; ++bj) { const int col = col0 + bj * HALF, t = col >> 4; f32x4 o0, o1;
#pragma unroll
                    for (int e = 0; e < 4; ++e) { o0[e] = gelu_tanh(acc[ai][bj][m][0][e]); o1[e] = gelu_tanh(acc[ai][bj][m][1][e]); }
                    *(u32x4*)(Y + (size_t)(bc * 64 + t) * 1024 + u.g * 16 + h0) = pack8(o0, o1); } }
    }
};
}

struct Args { const float* in[25]; float* out; unsigned char* ws; int ph_lo, ph_hi; };
enum { I_X = 0, I_P, I_NORMW, I_WIN, I_ARE, I_AIM, I_LOGDT, I_BRE, I_BIM, I_CRE, I_CIM, I_S5D, I_WGLU, I_BGLU, I_CONVW, I_CONVB, I_DTBIAS, I_ALOG, I_SSDD, I_SSDNW, I_WOUT, I_PLENW, I_WGATE, I_WPLE, I_FINALW };
constexpr int N_PHASES = 8;
#ifndef DBL_PHASE
#define DBL_PHASE -1
#endif

__device__ __forceinline__ void p0_transpose_item(const float* W, int ldw, int K, int N, bf16_t* WT, const float* sc, LAS float* scr, int item, int lane) {
    const int nblk = N / 32, kb = item / nblk, nb = item % nblk, k0 = 64 * kb, n0 = 32 * nb;
    float v[32];
#pragma unroll
    for (int i = 0; i < 32; ++i) v[i] = W[(size_t)(k0 + 2 * i + (lane >> 5)) * ldw + n0 + (lane & 31)];
    if (sc) {
        float s2[32];
#pragma unroll
        for (int i = 0; i < 32; ++i) s2[i] = sc[k0 + 2 * i + (lane >> 5)];
#pragma unroll
        for (int i = 0; i < 32; ++i) v[i] *= s2[i];
    }
#pragma unroll
    for (int i = 0; i < 32; ++i) scr[(2 * i + (lane >> 5)) * 33 + (lane & 31)] = v[i];
    asm volatile("s_waitcnt lgkmcnt(0)" ::: "memory");
    const int c = lane & 7;
#pragma unroll
    for (int j = 0; j < 4; ++j) { const int n = (lane >> 3) + 8 * j; const LAS float* s = scr + (8 * c) * 33 + n;
        u32x4 o; o.x = cvt_pk_bf16(s[0 * 33], s[1 * 33]); o.y = cvt_pk_bf16(s[2 * 33], s[3 * 33]); o.z = cvt_pk_bf16(s[4 * 33], s[5 * 33]); o.w = cvt_pk_bf16(s[6 * 33], s[7 * 33]);
        *(u32x4*)(WT + (size_t)(n0 + n) * K + k0 + 8 * c) = o; }
    asm volatile("s_waitcnt lgkmcnt(0)" ::: "memory");
}

__device__ __forceinline__ void p0_prologue(const Args& a, LAS unsigned char* lds, int vcu, int G) {
    const int tid = threadIdx.x, lane = tid & 63, wave = __builtin_amdgcn_readfirstlane(tid >> 6);
    unsigned char* ws = a.ws;
    LAS float* WD = (LAS float*)lds;
    LAS float* PWr = (LAS float*)(lds + 65536);
    LAS float* PWi = PWr + 65 * 64;
    LAS float* Cr = PWi + 65 * 64;
    LAS float* Ci = Cr + 1024;
    LAS float* Br = Ci + 1024;
    LAS float* Bi = Br + 1024;
    const int g = vcu >> 2, q = vcu & 3, t4 = tid - 256;
    if (wave < 4) {
        f32x4 wr_[4][4]; float nw_[4];
#pragma unroll
        for (int i = 0; i < 4; ++i) { const int k = tid + 256 * i; nw_[i] = a.in[I_NORMW][k];
#pragma unroll
            for (int c = 0; c < 4; ++c) wr_[i][c] = *(const f32x4*)(a.in[I_WIN] + (size_t)k * NPROJ + 5120 + 4 * c); }
#pragma unroll
        for (int i = 0; i < 4; ++i) { const int k = tid + 256 * i;
#pragma unroll
            for (int c = 0; c < 4; ++c) *(LAS f32x4*)(WD + ((((k >> 8) * 4 + (k & 3)) * 4 + c) * 64 + ((k >> 2) & 63)) * 4) = wr_[i][c] * nw_[i]; }
    } else if (vcu < 256) {
        const float dt = expf(a.in[I_LOGDT][g]);
        { const int n = t4 & 63; const float are = a.in[I_ARE][g * 64 + n] * dt, aim = a.in[I_AIM][g * 64 + n] * dt;
#pragma unroll
            for (int i = 0; i < 17; ++i) { const int tau = (t4 >> 6) + 4 * i; if (tau < 65) {
                const float mag = __expf(are * (float)tau); const float ang = aim * (float)tau; const float sn = __sinf(ang), cs = __cosf(ang);
                PWr[tau * 64 + n] = mag * cs; PWi[tau * 64 + n] = mag * sn; } } }
        for (int e = t4; e < 1024; e += 256) { const int h = e >> 6, n = e & 63; Cr[e] = a.in[I_CRE][(g * 16 + h) * 64 + n]; Ci[e] = a.in[I_CIM][(g * 16 + h) * 64 + n]; }
        for (int e = t4; e < 1024; e += 256) { const int n = e >> 4;
            const float are = a.in[I_ARE][g * 64 + n], aim = a.in[I_AIM][g * 64 + n];
            const float mag = expf(are * dt); float sn, cs; sincosf(aim * dt, &sn, &cs);
            const float nr = mag * cs - 1.f, ni = mag * sn, den = are * are + aim * aim;
            const float qr = (nr * are + ni * aim) / den, qi = (ni * are - nr * aim) / den;
            const float br = a.in[I_BRE][g * 1024 + e], bi = a.in[I_BIM][g * 1024 + e];
            Br[e] = qr * br - qi * bi; Bi[e] = qr * bi + qi * br; }
    }
    __syncthreads();
    if (wave >= 4) {
        if (vcu < 256) {
#pragma unroll 1
            for (int it = 0; it < 2; ++it) {
                const int vt = t4 + 256 * it;
                {
                    const int tau = 16 * q + (vt >> 5), h = (vt >> 1) & 15, hp0 = (vt & 1) * 8;
                    float s[8];
#pragma unroll
                    for (int j = 0; j < 8; ++j) s[j] = 0.f;
                    for (int n = 0; n < 64; ++n) { const float pr = PWr[tau * 64 + n], pi = PWi[tau * 64 + n], cr = Cr[h * 64 + n], ci = Ci[h * 64 + n];
                        const float xr = cr * pr - ci * pi, xi = cr * pi + ci * pr;
#pragma unroll
                        for (int j = 0; j < 8; ++j) s[j] += xr * Br[n * 16 + hp0 + j] - xi * Bi[n * 16 + hp0 + j]; }
                    if (tau == 0) { const float dv = a.in[I_S5D][g * 16 + h];
#pragma unroll
                        for (int j = 0; j < 8; ++j) if (hp0 + j == h) s[j] += dv; }
                    bf16_t* KR = (bf16_t*)(ws + WS_KR) + (size_t)g * 32768 + (size_t)h * 2048 + (63 - tau) * 16 + hp0;
                    u32x4 o; o.x = cvt_pk_bf16(s[0], s[1]); o.y = cvt_pk_bf16(s[2], s[3]); o.z = cvt_pk_bf16(s[4], s[5]); o.w = cvt_pk_bf16(s[6], s[7]);
                    *(u32x4*)KR = o;
                    bf16_t* KZ = (bf16_t*)(ws + WS_KR) + (size_t)g * 32768 + (size_t)(vt >> 5) * 2048 + (64 + 16 * q) * 16 + (vt & 31) * 8;
                    *(u32x4*)KZ = (u32x4){0u, 0u, 0u, 0u};
                }
                {
                    const int t = 16 * q + (vt >> 5), h = (vt >> 1) & 15, kh = vt & 1;
                    bf16_t* QP = (bf16_t*)(ws + WS_Q) + ((size_t)g * 1024 + t * 16 + h) * 128 + kh * 64;
#pragma unroll 2
                    for (int n0 = 0; n0 < 64; n0 += 8) { float v[8];
#pragma unroll
                        for (int j = 0; j < 8; ++j) { const int n = n0 + j; const float pr = PWr[(t + 1) * 64 + n], pi = PWi[(t + 1) * 64 + n], cr = Cr[h * 64 + n], ci = Ci[h * 64 + n];
                            v[j] = kh ? -(cr * pi + ci * pr) : (cr * pr - ci * pi); }
                        u32x4 o; o.x = cvt_pk_bf16(v[0], v[1]); o.y = cvt_pk_bf16(v[2], v[3]); o.z = cvt_pk_bf16(v[4], v[5]); o.w = cvt_pk_bf16(v[6], v[7]);
                        *(u32x4*)(QP + n0) = o; }
                }
                {
                    const int np = vt >> 2, n = np & 63, im = np >> 6, s0 = 16 * q + (vt & 3) * 4;
                    bf16_t* PP = (bf16_t*)(ws + WS_P) + ((size_t)g * 128 + np) * 1024 + s0 * 16;
#pragma unroll
                    for (int ds = 0; ds < 4; ++ds) { const int s = s0 + ds; const float pr = PWr[(63 - s) * 64 + n], pi = PWi[(63 - s) * 64 + n]; float v[16];
#pragma unroll
                        for (int j = 0; j < 16; ++j) { const float br = Br[n * 16 + j], bi = Bi[n * 16 + j]; v[j] = im ? (pr * bi + pi * br) : (pr * br - pi * bi); }
                        u32x4 o0, o1; o0.x = cvt_pk_bf16(v[0], v[1]); o0.y = cvt_pk_bf16(v[2], v[3]); o0.z = cvt_pk_bf16(v[4], v[5]); o0.w = cvt_pk_bf16(v[6], v[7]);
                        o1.x = cvt_pk_bf16(v[8], v[9]); o1.y = cvt_pk_bf16(v[10], v[11]); o1.z = cvt_pk_bf16(v[12], v[13]); o1.w = cvt_pk_bf16(v[14], v[15]);
                        *(u32x4*)(PP + ds * 16) = o0; *(u32x4*)(PP + ds * 16 + 8) = o1; }
                }
            }
            if (q == 0 && t4 < 64) { float* AB = (float*)(ws + WS_AB64) + (g * 64 + t4) * 2; AB[0] = PWr[64 * 64 + t4]; AB[1] = PWi[64 * 64 + t4]; }
        }
        LAS float* scr = (LAS float*)(lds + 115200 + (wave - 4) * 8448);
        const int gw = vcu * 4 + (wave - 4), NGW = G * 4;
        constexpr int I_IN = 16 * 160, I_GL = 16 * 32, I_OU = 32 * 32, I_GA = 16 * 32, I_PL = 4 * 32, NIT = I_IN + I_GL + I_OU + I_GA + I_PL;
        for (int it = gw; it < NIT; it += NGW) {
            int r = it;
            if (r < I_IN) { p0_transpose_item(a.in[I_WIN], NPROJ, 1024, 5120, (bf16_t*)(ws + WS_WIN), a.in[I_NORMW], scr, r, lane); continue; } r -= I_IN;
            if (r < I_GL) { p0_transpose_item(a.in[I_WGLU], 1024, 1024, 1024, (bf16_t*)(ws + WS_WGLU), nullptr, scr, r, lane); continue; } r -= I_GL;
            if (r < I_OU) { p0_transpose_item(a.in[I_WOUT], 1024, 2048, 1024, (bf16_t*)(ws + WS_WOUT), nullptr, scr, r, lane); continue; } r -= I_OU;
            if (r < I_GA) { p0_transpose_item(a.in[I_WGATE], 1024, 1024, 1024, (bf16_t*)(ws + WS_WGATE), a.in[I_PLENW], scr, r, lane); continue; } r -= I_GA;
            p0_transpose_item(a.in[I_WPLE], 1024, 256, 1024, (bf16_t*)(ws + WS_WPLE), nullptr, scr, r, lane);
        }
    } else {
        const int gw = vcu * 4 + wave, NGW = G * 4;
        const float* X = a.in[I_X]; bf16_t* XN = (bf16_t*)(ws + WS_XN); float* DT = (float*)(ws + WS_DT);
        const float bias = a.in[I_DTBIAS][(lane >> 1) & 15];
        f32x4 v[2][4];
        auto compute = [&](const int pr) {
            float s0 = 0.f, s1 = 0.f;
#pragma unroll
            for (int j = 0; j < 4; ++j) {
                s0 += (v[0][j][0] * v[0][j][0] + v[0][j][1] * v[0][j][1]) + (v[0][j][2] * v[0][j][2] + v[0][j][3] * v[0][j][3]);
                s1 += (v[1][j][0] * v[1][j][0] + v[1][j][1] * v[1][j][1]) + (v[1][j][2] * v[1][j][2] + v[1][j][3] * v[1][j][3]); }
            const float ms0 = wave_sum(s0) * (1.f / DM) + EPS, ms1 = wave_sum(s1) * (1.f / DM) + EPS; const float r0 = rsqrtf(ms0), r1_ = rsqrtf(ms1);
            if (lane < 2) ((float*)(ws + WS_RINV))[2 * pr + lane] = sqrtf(lane ? ms1 : ms0);
            u32x2* o8 = (u32x2*)(XN + (size_t)(2 * pr) * DM) + lane;
            f32x2 dd0[8], dd1[8];
#pragma unroll
            for (int h = 0; h < 8; ++h) { dd0[h] = (f32x2){0.f, 0.f}; dd1[h] = (f32x2){0.f, 0.f}; }
#pragma unroll
            for (int j = 0; j < 4; ++j) { v[0][j] = v[0][j] * r0; v[1][j] = v[1][j] * r1_;
                u32x2 w; w.x = cvt_pk_bf16(v[0][j][0], v[0][j][1]); w.y = cvt_pk_bf16(v[0][j][2], v[0][j][3]); o8[64 * j] = w;
                w.x = cvt_pk_bf16(v[1][j][0], v[1][j][1]); w.y = cvt_pk_bf16(v[1][j][2], v[1][j][3]); o8[256 + 64 * j] = w; }
            f32x4 wc[4], wn[4];
#pragma unroll
            for (int c = 0; c < 4; ++c) { wc[c] = *(const LAS f32x4*)(WD + (c * 64 + lane) * 4); wn[c] = wc[c]; }
#pragma unroll
            for (int it = 0; it < 16; ++it) {
                if (it + 1 < 16) {
#pragma unroll
                    for (int c = 0; c < 4; ++c) wn[c] = *(const LAS f32x4*)(WD + (((it + 1) * 4 + c) * 64 + lane) * 4); }
                __builtin_amdgcn_sched_barrier(0);
                const float x0 = v[0][it >> 2][it & 3], x1 = v[1][it >> 2][it & 3];
                const f32x2 xx0 = (f32x2){x0, x0}, xx1 = (f32x2){x1, x1};
#pragma unroll
                for (int c = 0; c < 4; ++c) { const f32x2 wl = (f32x2){wc[c][0], wc[c][1]}, wh = (f32x2){wc[c][2], wc[c][3]};
                    dd0[2 * c] = __builtin_elementwise_fma(xx0, wl, dd0[2 * c]); dd0[2 * c + 1] = __builtin_elementwise_fma(xx0, wh, dd0[2 * c + 1]);
                    dd1[2 * c] = __builtin_elementwise_fma(xx1, wl, dd1[2 * c]); dd1[2 * c + 1] = __builtin_elementwise_fma(xx1, wh, dd1[2 * c + 1]); }
                __builtin_amdgcn_sched_barrier(0);
#pragma unroll
                for (int c = 0; c < 4; ++c) wc[c] = wn[c];
            }
            float d0[16], d1[16];
#pragma unroll
            for (int h = 0; h < 8; ++h) { d0[2 * h] = dd0[h][0]; d0[2 * h + 1] = dd0[h][1]; d1[2 * h] = dd1[h][0]; d1[2 * h + 1] = dd1[h][1]; }
            const bool b5 = lane & 32, b4 = lane & 16, b3 = lane & 8, b2 = lane & 4, b1 = lane & 2;
            float q16[16], q8[8], q4[4], q2[2], q1;
#pragma unroll
            for (int i = 0; i < 16; ++i) { const float keep = b5 ? d1[i] : d0[i], send = b5 ? d0[i] : d1[i]; q16[i] = keep + __shfl_xor(send, 32); }
#pragma unroll
            for (int i = 0; i < 8; ++i) { const float keep = b4 ? q16[i + 8] : q16[i], send = b4 ? q16[i] : q16[i + 8]; q8[i] = keep + __shfl_xor(send, 16); }
#pragma unroll
            for (int i = 0; i < 4; ++i) { const float keep = b3 ? q8[i + 4] : q8[i], send = b3 ? q8[i] : q8[i + 4]; q4[i] = keep + __shfl_xor(send, 8); }
#pragma unroll
            for (int i = 0; i < 2; ++i) { const float keep = b2 ? q4[i + 2] : q4[i], send = b2 ? q4[i] : q4[i + 2]; q2[i] = keep + __shfl_xor(send, 4); }
            { const float keep = b1 ? q2[1] : q2[0], send = b1 ? q2[0] : q2[1]; q1 = keep + __shfl_xor(send, 2); }
            q1 += __shfl_xor(q1, 1);
            if ((lane & 1) == 0) DT[(size_t)(2 * pr + (lane >> 5)) * 16 + ((lane >> 1) & 15)] = softplusf_(q1 + bias);
        };
        auto take = [&](f32x4 (&vs)[2][4], const int prn) {
#pragma unroll
            for (int rr = 0; rr < 2; ++rr)
#pragma unroll
                for (int j = 0; j < 4; ++j)
#pragma unroll
                    for (int e = 0; e < 4; ++e) { float t; asm volatile("v_mov_b32 %0, %1" : "=v"(t) : "v"(vs[rr][j][e])); v[rr][j][e] = t; }
            asm volatile("" ::: "memory");
            const int pc = prn < M / 2 ? prn : M / 2 - 1;
#pragma unroll
            for (int rr = 0; rr < 2; ++rr)
#pragma unroll
                for (int j = 0; j < 4; ++j) vs[rr][j] = *((const f32x4*)(X + (size_t)(2 * pc + rr) * DM) + lane + 64 * j);
        };
        f32x4 vA[2][4], vB[2][4];
#pragma unroll
        for (int rr = 0; rr < 2; ++rr)
#pragma unroll
            for (int j = 0; j < 4; ++j) { vA[rr][j] = *((const f32x4*)(X + (size_t)(2 * gw + rr) * DM) + lane + 64 * j); }
#pragma unroll
        for (int rr = 0; rr < 2; ++rr)
#pragma unroll
            for (int j = 0; j < 4; ++j) { vB[rr][j] = *((const f32x4*)(X + (size_t)(2 * (gw + NGW) + rr) * DM) + lane + 64 * j); }
        take(vA, gw + 2 * NGW);
#pragma unroll 1
        for (int pr = gw; pr < M / 2; pr += 2 * NGW) {
            compute(pr);
            take(vB, pr + 3 * NGW);
            compute(pr + NGW);
            take(vA, pr + 4 * NGW);
        }
    }
    {
        const int gw = vcu * NWAVES + wave, NGW = G * NWAVES;
        const float* Pp = a.in[I_P]; bf16_t* PB = (bf16_t*)(ws + WS_PB);
        for (int m0 = gw; m0 < M; m0 += 8 * NGW) { f32x4 pv[8];
#pragma unroll
            for (int i = 0; i < 8; ++i) pv[i] = *((const f32x4*)(Pp + (size_t)(m0 + i * NGW) * PLE) + lane);
#pragma unroll
            for (int i = 0; i < 8; ++i) { u32x2 w; w.x = cvt_pk_bf16(pv[i][0], pv[i][1]); w.y = cvt_pk_bf16(pv[i][2], pv[i][3]); *((u32x2*)(PB + (size_t)(m0 + i * NGW) * PLE) + lane) = w; } }
    }
}

__device__ __forceinline__ void s5_chunk_scan(const Args& a, LAS unsigned char* lds) {
    const int tid = threadIdx.x;
    const int wv = __builtin_amdgcn_readfirstlane(tid >> 6), n = tid & 63;
    unsigned char* ws = a.ws;
    LAS float* EX = (LAS float*)(lds + LDSCTL_OFF + 1024);
    for (int blk = blockIdx.x; blk < 256; blk += gridDim.x) {
        const int g = blk >> 2, b = blk & 3;
        float sr[32], si[32];
        float abr = 0.f, abi = 0.f;
        if (wv < 4) {
            abr = ((const float*)(ws + WS_AB64))[(g * 64 + n) * 2]; abi = ((const float*)(ws + WS_AB64))[(g * 64 + n) * 2 + 1];
            const float* S0 = (const float*)(ws + WS_S5S) + (size_t)(g * 512 + b * NCH + wv * 32) * 128;
            const float* S1 = (const float*)(ws + WS_S5S2) + (size_t)(g * 512 + b * NCH + wv * 32) * 128;
#pragma unroll
            for (int j = 0; j < 32; ++j) { sr[j] = S0[j * 128 + n] + S1[j * 128 + n]; si[j] = S0[j * 128 + 64 + n] + S1[j * 128 + 64 + n]; }
            float hr = 0.f, hi = 0.f;
#pragma unroll
            for (int j = 0; j < 32; ++j) { const float nr = abr * hr - abi * hi + sr[j], ni = abr * hi + abi * hr + si[j]; sr[j] = hr; si[j] = hi; hr = nr; hi = ni; }
            EX[wv * 128 + n] = hr; EX[wv * 128 + 64 + n] = hi;
        }
        __syncthreads();
        if (wv < 4) {
            float pr = abr, pi = abi;
#pragma unroll
            for (int q = 0; q < 5; ++q) { const float t = pr * pr - pi * pi; pi = 2.f * pr * pi; pr = t; }
            float cr = 0.f, ci = 0.f;
            for (int w2 = 0; w2 < wv; ++w2) { const float er = EX[w2 * 128 + n], ei = EX[w2 * 128 + 64 + n];
                const float nr = pr * cr - pi * ci + er, ni = pr * ci + pi * cr + ei; cr = nr; ci = ni; }
            bf16_t* AUp = (bf16_t*)(ws + WS_AU) + (size_t)(g * 512 + b * NCH + wv * 32) * AUW;
#pragma unroll
            for (int j = 0; j < 32; ++j) { AUp[(size_t)j * AUW + n] = f2bf(sr[j] + cr); AUp[(size_t)j * AUW + 64 + n] = f2bf(si[j] + ci);
                const float nr = abr * cr - abi * ci, ni = abr * ci + abi * cr; cr = nr; ci = ni; }
        }
        __syncthreads();
    }
}

namespace ssd {
constexpr int XT_OFF = 0, XT_STRIDE = 144;
constexpr int CM_OFF = 36864, NM_STRIDE = 272;
constexpr int BM_OFF = 54272;
constexpr int SH_OFF = 71680;
constexpr int SCL_OFF = 142336;
constexpr int ATAB_OFF = 143872, BDTAB_OFF = 144896;
constexpr int DTS_OFF = 108544, CSS_OFF = 109568, RED_OFF = 110592;
constexpr int BMT_OFF = 36864;

__device__ __forceinline__ int tsw(int r, int ck) { return r * XT_STRIDE + ((ck ^ ((r >> 3) & 7)) << 4); }
constexpr int WGT_OFF = 112640;

struct Raw { u32x4 x[7]; u32x4 bc[7]; float dt; };

__device__ __forceinline__ void load_weights(const Args& a, LAS unsigned char* lds, int g) {
    LAS float* W = (LAS float*)(lds + WGT_OFF);
    int tt = threadIdx.x; asm volatile("" : "+v"(tt));
    const int ch = tt < 256 ? g * 256 + tt : (tt < 384 ? 1024 + g * 128 + (tt - 256) : 1536 + g * 128 + (tt - 384));
    float v[5];
#pragma unroll
    for (int k = 0; k < 4; ++k) v[k] = a.in[I_CONVW][k * 2048 + ch];
    v[4] = a.in[I_CONVB][ch];
    const float nw = a.in[I_SSDNW][g * 256 + (tt & 255)];
    asm volatile("" ::: "memory");
#pragma unroll
    for (int k = 0; k < 5; ++k) W[tt + 512 * k] = v[k];
    if (tt < 256) W[2560 + tt] = nw;
    if (tt >= 256 && tt < 260) ((LAS float*)(lds + SCL_OFF + 1024))[tt - 256] = a.in[I_SSDD][g * 4 + tt - 256];
}
template <bool OUTP, int PART = 0>
__device__ __forceinline__ void load_raw(const Args& a, int u, Raw& raw) {
    const int tid = threadIdx.x, b = u >> 9, c = (u >> 2) & 127, g = u & 3;
    const size_t t0 = (size_t)b * SEQ + (size_t)c * 64;
    const bf16_t* XBC = (const bf16_t*)(a.ws + WS_XBC);
    const int wv = tid >> 6, l0 = ((((tid >> 3) & 7) + 8 * (wv & 1)) * 4), chx = g * 256 + ((tid & 7) + 8 * (wv >> 1)) * 8;
    const int chb = 1024 + (OUTP ? (tid >> 8) * 512 : 0) + g * 128 + ((tid & 7) + 8 * ((wv >> 1) & 1)) * 8;
    const bf16_t* px = XBC + ((long)t0 + l0 - 3) * 2048 + chx; const bf16_t* pb = XBC + ((long)t0 + l0 - 3) * 2048 + chb;
#pragma unroll
    for (int r = 0; r < 7; ++r) {
        if (PART != 2) raw.x[r] = *(const u32x4*)(px + r * 2048);
        if (PART != 1) { u32x4 wb = (u32x4){0u, 0u, 0u, 0u};
            if (OUTP || tid >= 256) wb = *(const u32x4*)(pb + r * 2048);
            raw.bc[r] = wb; } }
    if (PART != 2) { raw.dt = 0.f;
        if (tid < 256) raw.dt = ((const float*)(a.ws + WS_DT))[(t0 + (tid & 63)) * 16 + g * 4 + (tid >> 6)]; }
}
__device__ __forceinline__ void conv_regs(u32x4 (&rw)[7], const LAS float* W, int chl, bool zlo, bool c0u, float (&o)[4][8]) {
    f32x4 w0[4], w1[4];
#pragma unroll
    for (int k = 0; k < 4; ++k) { w0[k] = *(const LAS f32x4*)(W + k * 512 + chl); w1[k] = *(const LAS f32x4*)(W + k * 512 + chl + 4); }
    const f32x4 b0 = *(const LAS f32x4*)(W + 2048 + chl), b1 = *(const LAS f32x4*)(W + 2048 + chl + 4);
    f32x4 s0[4], s1[4];
#pragma unroll
    for (int dl = 0; dl < 4; ++dl) { s0[dl] = b0; s1[dl] = b1; }
    if (c0u) {
        asm volatile("" ::: "memory");
#pragma unroll
        for (int r = 0; r < 3; ++r) if (zlo) rw[r] = (u32x4){0u, 0u, 0u, 0u};
    }
#pragma unroll
    for (int r = 0; r < 7; ++r) { f32x4 x0, x1; pg8::unpack8(rw[r], x0, x1);
#pragma unroll
        for (int dl = 0; dl < 4; ++dl) { const int k = r - dl; if (k >= 0 && k < 4) { s0[dl] += w0[k] * x0; s1[dl] += w1[k] * x1; } } }
#pragma unroll
    for (int dl = 0; dl < 4; ++dl)
#pragma unroll
        for (int e = 0; e < 4; ++e) { o[dl][e] = siluf_(s0[dl][e]); o[dl][4 + e] = siluf_(s1[dl][e]); }
}
template <int CTRL, int ROW_MASK>
__device__ __forceinline__ float dpp_add(float v) {
    const int t = __builtin_amdgcn_update_dpp(0, __builtin_bit_cast(int, v), CTRL, ROW_MASK, 0xf, false);
    return v + __builtin_bit_cast(float, t);
}
template <bool TAB>
__device__ __forceinline__ void dt_cs(LAS unsigned char* lds, float dtv, float negA) {
    const int tid = threadIdx.x, lane = tid & 63, h = tid >> 6;
    if (tid < 256) {
        float v = dtv * negA;
        v = dpp_add<0x111, 0xf>(v); v = dpp_add<0x112, 0xf>(v); v = dpp_add<0x114, 0xf>(v); v = dpp_add<0x118, 0xf>(v);
        v = dpp_add<0x142, 0xa>(v);
        v = dpp_add<0x143, 0xc>(v);
        const float ce = __builtin_bit_cast(float, __builtin_amdgcn_readlane(__builtin_bit_cast(int, v), 63));
        ((LAS float*)(lds + DTS_OFF))[h * 64 + lane] = dtv; ((LAS float*)(lds + CSS_OFF))[h * 64 + lane] = v;
        ((LAS float*)(lds + SCL_OFF))[h * 64 + lane] = dtv * __expf(ce - v);
        if (TAB) {
            const float c16 = __builtin_bit_cast(float, __builtin_amdgcn_readlane(__builtin_bit_cast(int, v), 16)), c32 = __builtin_bit_cast(float, __builtin_amdgcn_readlane(__builtin_bit_cast(int, v), 32)),
                        c48 = __builtin_bit_cast(float, __builtin_amdgcn_readlane(__builtin_bit_cast(int, v), 48));
            const float own = lane < 32 ? c16 : (lane < 48 ? c32 : c48);
            ((LAS float*)(lds + ATAB_OFF))[h * 64 + lane] = __expf(v - own);
            ((LAS float*)(lds + BDTAB_OFF))[(h * 3 + 0) * 64 + lane] = dtv * __expf(c16 - v);
            ((LAS float*)(lds + BDTAB_OFF))[(h * 3 + 1) * 64 + lane] = dtv * __expf(c32 - v);
            ((LAS float*)(lds + BDTAB_OFF))[(h * 3 + 2) * 64 + lane] = dtv * __expf(c48 - v);
        }
    }
}
typedef __bf16 bf16x2_t __attribute__((ext_vector_type(2)));
__device__ __forceinline__ unsigned cvt2(float lo, float hi) { const f32x2 v = {lo, hi}; const bf16x2_t r = __builtin_convertvector(v, bf16x2_t); return __builtin_bit_cast(unsigned, r); }
__device__ __forceinline__ u32x2 pk4(float a, float b, float c, float d) { u32x2 w; w.x = cvt2(a, b); w.y = cvt2(c, d); return w; }

__device__ __forceinline__ int step_unit(int bx, int G, int s) { const int su = bx + (s >> SCH_LG) * G, j = s & (SCH - 1); return ((su >> (2 + NSC_LG)) << 9) | ((((su >> 2) & (NSC - 1)) * SCH + j) << 2) | (su & 3); }

__device__ __forceinline__ void states_unit(const Args& a, LAS unsigned char* lds, int u, int un, int& gl, float& negA, Raw& cur, f32x4 (&acc)[2][8], float& dprod) {
    const int tid = threadIdx.x, lane = tid & 63, wave = __builtin_amdgcn_readfirstlane(tid >> 6), fr = lane & 15, fq = lane >> 4;
    const LAS float* DTS = (const LAS float*)(lds + DTS_OFF); const LAS float* CSS = (const LAS float*)(lds + CSS_OFF); const LAS float* W = (const LAS float*)(lds + WGT_OFF);
    const int b = u >> 9, c = (u >> 2) & 127, g = u & 3, j = c & (SCH - 1);
    __syncthreads();
    if (g != gl) { load_weights(a, lds, g); gl = g; negA = -expf(a.in[I_ALOG][g * 4 + ((tid >> 6) & 3)]); }
    dt_cs<false>(lds, cur.dt, negA);
    __syncthreads();
    {
        const int oct = (tid & 7) + 8 * (wave >> 1), run = ((tid >> 3) & 7) + 8 * (wave & 1), l0 = run * 4, hh = oct >> 3; float o[4][8];
        conv_regs(cur.x, W, oct * 8, run == 0, c == 0, o);
        asm volatile("" ::: "memory");
        if (un >= 0) load_raw<false, 1>(a, un, cur);
        const f32x4 sc = *(const LAS f32x4*)(lds + SCL_OFF + (hh * 64 + l0) * 4);
#pragma unroll
        for (int jj = 0; jj < 8; ++jj) *(LAS u32x2*)(lds + XT_OFF + tsw(oct * 8 + jj, run >> 1) + (run & 1) * 8) = pk4(o[0][jj] * sc[0], o[1][jj] * sc[1], o[2][jj] * sc[2], o[3][jj] * sc[3]);
    }
    if (tid >= 256) {
        const int oct = (tid & 7) + 8 * ((wave >> 1) & 1), run = ((tid >> 3) & 7) + 8 * (wave & 1); float o[4][8];
        conv_regs(cur.bc, W, 256 + oct * 8, run == 0, c == 0, o);
#pragma unroll
        for (int jj = 0; jj < 8; ++jj) *(LAS u32x2*)(lds + BMT_OFF + tsw(oct * 8 + jj, run >> 1) + (run & 1) * 8) = pk4(o[0][jj], o[1][jj], o[2][jj], o[3][jj]);
    }
    asm volatile("" ::: "memory");
    if (un >= 0) load_raw<false, 2>(a, un, cur);
    __syncthreads();
    const int h = wave >> 1, ph = wave & 1;
    const float dec = __expf(CSS[h * 64 + 63]);
    if (j == 0) { dprod = dec;
#pragma unroll
        for (int pi = 0; pi < 2; ++pi)
#pragma unroll
            for (int nj = 0; nj < 8; ++nj) acc[pi][nj] = (f32x4){0.f, 0.f, 0.f, 0.f};
    } else { dprod *= dec;
#pragma unroll
        for (int pi = 0; pi < 2; ++pi)
#pragma unroll
            for (int nj = 0; nj < 8; ++nj) acc[pi][nj] = acc[pi][nj] * dec; }
#pragma unroll
    for (int ks = 0; ks < 2; ++ks) { bf16x8 xf[2];
#pragma unroll
        for (int pi = 0; pi < 2; ++pi) xf[pi] = *(const LAS bf16x8*)(lds + XT_OFF + tsw(h * 64 + ph * 32 + pi * 16 + fr, ks * 4 + fq));
        bf16x8 bfr[8];
#pragma unroll
        for (int nj = 0; nj < 8; ++nj) bfr[nj] = *(const LAS bf16x8*)(lds + BMT_OFF + tsw(nj * 16 + fr, ks * 4 + fq));
        __builtin_amdgcn_sched_barrier(0);
#pragma unroll
        for (int nj = 0; nj < 8; ++nj)
#pragma unroll
            for (int pi = 0; pi < 2; ++pi) acc[pi][nj] = __builtin_amdgcn_mfma_f32_16x16x32_bf16(bfr[nj], xf[pi], acc[pi][nj], 0, 0, 0); }
    if (j == SCH - 1) {
        bf16_t* STp = (bf16_t*)a.out + ((size_t)(b * NSC + (c >> SCH_LG)) * 16 + g * 4 + h) * 8192;
#pragma unroll
        for (int pi = 0; pi < 2; ++pi)
#pragma unroll
            for (int nj = 0; nj < 8; ++nj) *(u32x2*)(STp + (ph * 32 + pi * 16 + fr) * 128 + nj * 16 + 4 * fq) = pk4(acc[pi][nj][0], acc[pi][nj][1], acc[pi][nj][2], acc[pi][nj][3]);
        if (ph == 0 && lane == 0) ((float*)(a.ws + WS_CD))[(b * NSC + (c >> SCH_LG)) * 16 + g * 4 + h] = dprod;
    }
}
__device__ __forceinline__ void states_phase(const Args& a, LAS unsigned char* lds, int bx, int G) {
    const int NSU = NB * NSC * 4;
    if (bx >= NSU) return;
    const int nsteps = SCH * ((NSU - bx + G - 1) / G);
    Raw ra; load_raw<false>(a, step_unit(bx, G, 0), ra);
    f32x4 acc[2][8]; float dprod = 1.f;
#pragma unroll
    for (int pi = 0; pi < 2; ++pi)
#pragma unroll
        for (int nj = 0; nj < 8; ++nj) acc[pi][nj] = (f32x4){0.f, 0.f, 0.f, 0.f};
    int gl = -1; float negA = 0.f;
    for (int s = 0; s < nsteps; ++s) states_unit(a, lds, step_unit(bx, G, s), (s + 1 < nsteps) ? step_unit(bx, G, s + 1) : -1, gl, negA, ra, acc, dprod);
}

__device__ __forceinline__ void state_scan(const Args& a) {
    const int tid = threadIdx.x;
    const float* CD = (const float*)(a.ws + WS_CD);
    for (int gt = blockIdx.x * NTHR + tid; gt < NB * 32768; gt += gridDim.x * NTHR) {
        const int b = gt >> 15, rem = gt & 32767, h = rem >> 11;
        bf16_t* base = (bf16_t*)a.out + (size_t)b * NSC * 131072 + (size_t)rem * 4;
        f32x4 st = (f32x4){0.f, 0.f, 0.f, 0.f};
        for (int c0 = 0; c0 < NSC; c0 += 16) {
            u32x2 lw[16]; float dc[16];
#pragma unroll
            for (int j = 0; j < 16; ++j) { lw[j] = *(const u32x2*)(base + (size_t)(c0 + j) * 131072); dc[j] = CD[(b * NSC + c0 + j) * 16 + h]; }
#pragma unroll
            for (int j = 0; j < 16; ++j) { *(u32x2*)(base + (size_t)(c0 + j) * 131072) = pk4(st[0], st[1], st[2], st[3]);
                const f32x4 lv = (f32x4){bflo(lw[j].x), bfhi(lw[j].x), bflo(lw[j].y), bfhi(lw[j].y)}; st = st * dc[j] + lv; }
        }
    }
}

constexpr int BMT2_OFF = 123904;

struct Late { bf16x8 pf[2][4]; u32x2 zw[4][2]; };
__device__ __forceinline__ bf16x8 cat8(const u32x2 lo, const u32x2 hi) { const u32x4 w = (u32x4){lo.x, lo.y, hi.x, hi.y}; return __builtin_bit_cast(bf16x8, w); }
__device__ __forceinline__ void load_state(const Args& a, int u, int h, int ph, int fr, int fq, Late& L) {
    const int b = u >> 9, c = (u >> 2) & 127, g = u & 3;
    const bf16_t* STp = (const bf16_t*)a.out + ((size_t)(b * NSC + (c >> SCH_LG)) * 16 + g * 4 + h) * 8192;
#pragma unroll
    for (int pt = 0; pt < 2; ++pt)
#pragma unroll
        for (int ks = 0; ks < 4; ++ks) { const bf16_t* p = STp + (ph * 32 + pt * 16 + fr) * 128 + ks * 32 + 4 * fq;
            L.pf[pt][ks] = cat8(*(const u32x2*)p, *(const u32x2*)(p + 16)); }
}
__device__ __forceinline__ void load_z(const Args& a, int u, int h, int ph, int fr, int fq, Late& L) {
    const int b = u >> 9, c = (u >> 2) & 127, g = u & 3;
    const size_t t0 = (size_t)b * SEQ + (size_t)c * 64;
    const bf16_t* ZZ = (const bf16_t*)(a.ws + WS_ZZ);
#pragma unroll
    for (int mi = 0; mi < 4; ++mi)
#pragma unroll
        for (int nj = 0; nj < 2; ++nj) L.zw[mi][nj] = *(const u32x2*)(ZZ + (t0 + mi * 16 + fr) * 2048 + 1024 + g * 256 + h * 64 + ph * 32 + nj * 16 + 4 * fq);
}
__device__ __forceinline__ void out_unit(const Args& a, LAS unsigned char* lds, int u, int un, int& gl, float& negA, Raw& cur, Late& L) {
    const int tid = threadIdx.x, lane = tid & 63, wave = __builtin_amdgcn_readfirstlane(tid >> 6), fr = lane & 15, fq = lane >> 4;
    bf16_t* ZZ = (bf16_t*)(a.ws + WS_ZZ);
    const LAS float* DTS = (const LAS float*)(lds + DTS_OFF); const LAS float* CSS = (const LAS float*)(lds + CSS_OFF); LAS float* RED = (LAS float*)(lds + RED_OFF);
    const LAS float* W = (const LAS float*)(lds + WGT_OFF);
    const int h = wave >> 1, ph = wave & 1;
    const int b = u >> 9, c = (u >> 2) & 127, g = u & 3, j = c & (SCH - 1);
    const size_t t0 = (size_t)b * SEQ + (size_t)c * 64;
    __syncthreads();
    if (j == 0) load_state(a, u, h, ph, fr, fq, L);
    if (g != gl) { load_weights(a, lds, g); gl = g; negA = -expf(a.in[I_ALOG][g * 4 + ((tid >> 6) & 3)]); __syncthreads(); }
    dt_cs<true>(lds, cur.dt, negA);
    {
        const int oct = (tid & 7) + 8 * (wave >> 1), run = ((tid >> 3) & 7) + 8 * (wave & 1); float o[4][8];
        conv_regs(cur.x, W, oct * 8, run == 0, c == 0, o);
        asm volatile("" ::: "memory");
        if (un >= 0) load_raw<true, 1>(a, un, cur);
#pragma unroll
        for (int jj = 0; jj < 8; ++jj) *(LAS u32x2*)(lds + XT_OFF + tsw(oct * 8 + jj, run >> 1) + (run & 1) * 8) = pk4(o[0][jj], o[1][jj], o[2][jj], o[3][jj]);
    }
    {
        const int sel = tid >> 8, oct = (tid & 7) + 8 * ((wave >> 1) & 1), run = ((tid >> 3) & 7) + 8 * (wave & 1), l0 = run * 4; float o[4][8];
        conv_regs(cur.bc, W, 256 + sel * 128 + oct * 8, run == 0, c == 0, o);
        const int off = sel ? CM_OFF : BM_OFF;
#pragma unroll
        for (int dl = 0; dl < 4; ++dl) { u32x4 w; w.x = cvt2(o[dl][0], o[dl][1]); w.y = cvt2(o[dl][2], o[dl][3]); w.z = cvt2(o[dl][4], o[dl][5]); w.w = cvt2(o[dl][6], o[dl][7]);
            *(LAS u32x4*)(lds + off + (l0 + dl) * NM_STRIDE + oct * 16) = w; }
        if (sel == 0 && j < SCH - 1) {
#pragma unroll
            for (int jj = 0; jj < 8; ++jj) *(LAS u32x2*)(lds + BMT2_OFF + tsw(oct * 8 + jj, run >> 1) + (run & 1) * 8) = pk4(o[0][jj], o[1][jj], o[2][jj], o[3][jj]); }
    }
    asm volatile("" ::: "memory");
    if (un >= 0) load_raw<true, 2>(a, un, cur);
    load_z(a, u, h, ph, fr, fq, L);
    __syncthreads();
    {
        const int mi = wave >> 1, nj0 = (wave & 1) * 2;
        f32x4 accG[2] = {(f32x4){0.f, 0.f, 0.f, 0.f}, (f32x4){0.f, 0.f, 0.f, 0.f}};
        {
            bf16x8 cfr[4], bfr[4][2];
#pragma unroll
            for (int ks = 0; ks < 4; ++ks) { cfr[ks] = *(const LAS bf16x8*)(lds + CM_OFF + (mi * 16 + fr) * NM_STRIDE + (ks * 32 + fq * 8) * 2);
#pragma unroll
                for (int jj = 0; jj < 2; ++jj) bfr[ks][jj] = *(const LAS bf16x8*)(lds + BM_OFF + ((nj0 + jj) * 16 + fr) * NM_STRIDE + (ks * 32 + fq * 8) * 2); }
            __builtin_amdgcn_sched_barrier(0);
#pragma unroll
            for (int ks = 0; ks < 4; ++ks)
#pragma unroll
                for (int jj = 0; jj < 2; ++jj) accG[jj] = __builtin_amdgcn_mfma_f32_16x16x32_bf16(bfr[ks][jj], cfr[ks], accG[jj], 0, 0, 0);
        }
        const int l = mi * 16 + fr;
#pragma unroll
        for (int hh = 0; hh < 4; ++hh) { const float csl = CSS[hh * 64 + l], Dhh = ((const LAS float*)(lds + SCL_OFF + 1024))[hh];
#pragma unroll
            for (int jj = 0; jj < 2; ++jj) { const int nj = nj0 + jj, s0 = nj * 16 + 4 * fq; float v[4];
                if (nj > mi) {
#pragma unroll
                    for (int e = 0; e < 4; ++e) v[e] = 0.f;
                } else if (nj == mi) {
                    const f32x4 css = *(const LAS f32x4*)(CSS + hh * 64 + s0), dts = *(const LAS f32x4*)(DTS + hh * 64 + s0);
#pragma unroll
                    for (int e = 0; e < 4; ++e) { const float t = accG[jj][e] * __expf(csl - css[e]) * dts[e]; v[e] = (s0 + e < l) ? t : ((s0 + e == l) ? t + Dhh : 0.f); }
                } else {
                    const float al = ((const LAS float*)(lds + ATAB_OFF))[hh * 64 + l];
                    const f32x4 bd = *(const LAS f32x4*)(lds + BDTAB_OFF + ((hh * 3 + mi - 1) * 64 + s0) * 4);
#pragma unroll
                    for (int e = 0; e < 4; ++e) v[e] = accG[jj][e] * al * bd[e];
                }
                *(LAS u32x2*)(lds + SH_OFF + hh * 9216 + l * XT_STRIDE + s0 * 2) = pk4(v[0], v[1], v[2], v[3]); } }
    }
    __syncthreads();
    f32x4 gv[4][2];
#pragma unroll
    for (int half = 0; half < 2; ++half) {
        f32x4 accD[2][2], accO[2][2];
#pragma unroll
        for (int mm = 0; mm < 2; ++mm)
#pragma unroll
            for (int nj = 0; nj < 2; ++nj) { accD[mm][nj] = (f32x4){0.f, 0.f, 0.f, 0.f}; accO[mm][nj] = (f32x4){0.f, 0.f, 0.f, 0.f}; }
        {
            bf16x8 xf[2][2], sf[2][2], cf[4][2];
#pragma unroll
            for (int ks = 0; ks < 2; ++ks) {
#pragma unroll
                for (int nj = 0; nj < 2; ++nj) xf[ks][nj] = *(const LAS bf16x8*)(lds + XT_OFF + tsw(h * 64 + ph * 32 + nj * 16 + fr, ks * 4 + fq));
#pragma unroll
                for (int mm = 0; mm < 2; ++mm) sf[ks][mm] = *(const LAS bf16x8*)(lds + SH_OFF + h * 9216 + ((half * 2 + mm) * 16 + fr) * XT_STRIDE + (ks * 32 + fq * 8) * 2); }
            __builtin_amdgcn_sched_barrier(0);
#pragma unroll
            for (int ks = 0; ks < 4; ++ks)
#pragma unroll
                for (int mm = 0; mm < 2; ++mm) { const LAS unsigned char* cp = lds + CM_OFF + ((half * 2 + mm) * 16 + fr) * NM_STRIDE + (ks * 32 + 4 * fq) * 2;
                    cf[ks][mm] = cat8(*(const LAS u32x2*)cp, *(const LAS u32x2*)(cp + 32)); }
            __builtin_amdgcn_sched_barrier(0);
#pragma unroll
            for (int ks = 0; ks < 2; ++ks)
#pragma unroll
                for (int mm = 0; mm < 2; ++mm)
#pragma unroll
                    for (int nj = 0; nj < 2; ++nj) accD[mm][nj] = __builtin_amdgcn_mfma_f32_16x16x32_bf16(xf[ks][nj], sf[ks][mm], accD[mm][nj], 0, 0, 0);
#pragma unroll
            for (int ks = 0; ks < 4; ++ks)
#pragma unroll
                for (int mm = 0; mm < 2; ++mm)
#pragma unroll
                    for (int nj = 0; nj < 2; ++nj) accO[mm][nj] = __builtin_amdgcn_mfma_f32_16x16x32_bf16(L.pf[nj][ks], cf[ks][mm], accO[mm][nj], 0, 0, 0);
        }
#pragma unroll
        for (int mm = 0; mm < 2; ++mm) { const int mi = half * 2 + mm, l = mi * 16 + fr; const float el = __expf(CSS[h * 64 + l]); float ss = 0.f;
#pragma unroll
            for (int nj = 0; nj < 2; ++nj) { const int p0 = ph * 32 + nj * 16 + 4 * fq;
                const f32x4 z = (f32x4){bflo(L.zw[mi][nj].x), bfhi(L.zw[mi][nj].x), bflo(L.zw[mi][nj].y), bfhi(L.zw[mi][nj].y)};
#pragma unroll
                for (int e = 0; e < 4; ++e) {
                    const float y = accD[mm][nj][e] + el * accO[mm][nj][e]; const float gg = y * z[e]  ; gv[mi][nj][e] = gg; ss += gg * gg; } }
            ss += __shfl_xor(ss, 16); ss += __shfl_xor(ss, 32);
            if (fq == 0) RED[wave * 64 + l] = ss; }
        asm volatile("" ::: "memory");
    }
    __syncthreads();
    { float tdt; asm volatile("v_mov_b32 %0, %1" : "=v"(tdt) : "v"(cur.dt)); cur.dt = tdt; }
#pragma unroll
    for (int mi = 0; mi < 4; ++mi) { const int l = mi * 16 + fr; float tot = 0.f;
#pragma unroll
        for (int w = 0; w < 8; ++w) tot += RED[w * 64 + l];
        const float r = rsqrtf(tot * (1.f / 256.f) + EPS);
#pragma unroll
        for (int nj = 0; nj < 2; ++nj) { const int p0 = ph * 32 + nj * 16 + 4 * fq; const f32x4 nw = *(const LAS f32x4*)(W + 2560 + h * 64 + p0);
            *(u32x2*)(ZZ + (t0 + l) * 2048 + 1024 + g * 256 + h * 64 + p0) = pk4(gv[mi][nj][0] * r * nw[0], gv[mi][nj][1] * r * nw[1], gv[mi][nj][2] * r * nw[2], gv[mi][nj][3] * r * nw[3]); } }
    if (j < SCH - 1) {
        const float ce = CSS[h * 64 + 63], dec = __expf(ce);
        f32x4 as[2][8];
#pragma unroll
        for (int pt = 0; pt < 2; ++pt)
#pragma unroll
            for (int ks = 0; ks < 4; ++ks) { const u32x4 w = __builtin_bit_cast(u32x4, L.pf[pt][ks]);
                as[pt][2 * ks] = (f32x4){bflo(w.x), bfhi(w.x), bflo(w.y), bfhi(w.y)} * dec; as[pt][2 * ks + 1] = (f32x4){bflo(w.z), bfhi(w.z), bflo(w.w), bfhi(w.w)} * dec; }
#pragma unroll
        for (int k2 = 0; k2 < 2; ++k2) {
            const int lb = h * 64 + k2 * 32 + fq * 8;
            const f32x4 s0 = *(const LAS f32x4*)(lds + SCL_OFF + lb * 4), s1 = *(const LAS f32x4*)(lds + SCL_OFF + lb * 4 + 16);
            bf16x8 xf[2];
#pragma unroll
            for (int pt = 0; pt < 2; ++pt) {
                const u32x4 xw = *(const LAS u32x4*)(lds + XT_OFF + tsw(h * 64 + ph * 32 + pt * 16 + fr, k2 * 4 + fq));
                f32x4 x0, x1; pg8::unpack8(xw, x0, x1); x0 = x0 * s0; x1 = x1 * s1;
                const u32x4 xs = (u32x4){cvt2(x0[0], x0[1]), cvt2(x0[2], x0[3]), cvt2(x1[0], x1[1]), cvt2(x1[2], x1[3])};
                xf[pt] = __builtin_bit_cast(bf16x8, xs); }
            bf16x8 bfr[8];
#pragma unroll
            for (int nt = 0; nt < 8; ++nt) bfr[nt] = *(const LAS bf16x8*)(lds + BMT2_OFF + tsw(nt * 16 + fr, k2 * 4 + fq));
            __builtin_amdgcn_sched_barrier(0);
#pragma unroll
            for (int nt = 0; nt < 8; ++nt)
#pragma unroll
                for (int pt = 0; pt < 2; ++pt) as[pt][nt] = __builtin_amdgcn_mfma_f32_16x16x32_bf16(bfr[nt], xf[pt], as[pt][nt], 0, 0, 0); }
#pragma unroll
        for (int pt = 0; pt < 2; ++pt)
#pragma unroll
            for (int ks = 0; ks < 4; ++ks) { const u32x4 w = (u32x4){cvt2(as[pt][2 * ks][0], as[pt][2 * ks][1]), cvt2(as[pt][2 * ks][2], as[pt][2 * ks][3]), cvt2(as[pt][2 * ks + 1][0], as[pt][2 * ks + 1][1]), cvt2(as[pt][2 * ks + 1][2], as[pt][2 * ks + 1][3])};
                L.pf[pt][ks] = __builtin_bit_cast(bf16x8, w); }
    }
}
__device__ __forceinline__ void out_phase(const Args& a, LAS unsigned char* lds, int bx, int G) {
    const int NSU = NB * NSC * 4;
    if (bx >= NSU) return;
    const int nsteps = SCH * ((NSU - bx + G - 1) / G);
    Raw ra; Late L;
    load_raw<true>(a, step_unit(bx, G, 0), ra);
    { float tdt; asm volatile("v_mov_b32 %0, %1" : "=v"(tdt) : "v"(ra.dt)); ra.dt = tdt; }
#pragma unroll
    for (int pt = 0; pt < 2; ++pt)
#pragma unroll
        for (int ks = 0; ks < 4; ++ks) L.pf[pt][ks] = (bf16x8){0, 0, 0, 0, 0, 0, 0, 0};
    int gl = -1; float negA = 0.f;
    for (int s = 0; s < nsteps; ++s) out_unit(a, lds, step_unit(bx, G, s), (s + 1 < nsteps) ? step_unit(bx, G, s + 1) : -1, gl, negA, ra, L);
}
}

__device__ __forceinline__ void final_norm(const Args& a, int vcu, int G) {
    const int tid = threadIdx.x, lane = tid & 63, wave = tid >> 6;
    const float* SS2 = (const float*)(a.ws + WS_SS2);
    const int gw = vcu * NWAVES + wave, NGW = G * NWAVES;
    f32x4 wv[4];
#pragma unroll
    for (int j = 0; j < 4; ++j) wv[j] = *((const f32x4*)a.in[I_FINALW] + lane + 64 * j);
    for (int m = gw; m < M; m += NGW) {
        const f32x4 s0 = *(const f32x4*)(SS2 + (size_t)m * 16), s1 = *(const f32x4*)(SS2 + (size_t)m * 16 + 4), s2 = *(const f32x4*)(SS2 + (size_t)m * 16 + 8), s3 = *(const f32x4*)(SS2 + (size_t)m * 16 + 12);
        const f32x4 st = (s0 + s1) + (s2 + s3);
        const float r = rsqrtf(((st[0] + st[1]) + (st[2] + st[3])) * (1.f / 1024.f) + EPS);
        f32x4* o = (f32x4*)(a.out + (size_t)m * DM) + lane;
#pragma unroll
        for (int j = 0; j < 4; ++j) { const f32x4 h = o[64 * j]; o[64 * j] = h * r * wv[j]; }
    }
}

__global__ void __launch_bounds__(NTHR, 2) mega_fwd(Args args) {
    extern __shared__ __attribute__((aligned(16))) unsigned char lds_raw[];
    LAS unsigned char* lds = (LAS unsigned char*)lds_raw;
    const int tid = threadIdx.x;
    const int G = gridDim.x; const int bx = blockIdx.x; const int vcu = (G % 8 == 0) ? (bx % 8) * (G / 8) + bx / 8 : bx;
    unsigned char* ws = args.ws;
    unsigned* ctl = (unsigned*)(ws + WS_CTL);
    for (int u = tid; u < (LDS_BYTES - LDSCTL_OFF) / 4; u += NTHR) ((LAS unsigned*)(lds + LDSCTL_OFF))[u] = 0u;
    __syncthreads();
    XcdBarrier bar; bar.bar = ctl + 4096; bar.x = 0; bar.st = nullptr;
    if (MK_N_LAUNCHES == 1) bar = xcd_barrier_post(ctl + 4096, (volatile LAS unsigned*)(lds + LDSCTL_OFF + 64));
    const int lo = args.ph_lo, hi = args.ph_hi;
#define IN(k) (lo <= (k) && (k) < hi)
#define SEAM(k) do { if (IN(k) && IN((k) + 1)) xcd_barrier(bar); } while (0)

    if (IN(0)) { for (int rep = 0; rep < (DBL_PHASE == 0 ? 2 : 1); ++rep) { p0_prologue(args, lds, vcu, G); if (DBL_PHASE == 0 && rep == 0) xcd_barrier(bar); } } SEAM(0);
    if (IN(1)) for (int rep = 0; rep < (DBL_PHASE == 1 ? 2 : 1); ++rep) {
        if (rep) xcd_barrier(bar);
        pg8::PlainOrder S; S.init(M, 5120, G, bx, ws + WS_XN, 2048, ws + WS_WIN, 2048, 16);
        pg8::EpiInProj E{(bf16_t*)(ws + WS_AU), (bf16_t*)(ws + WS_ZZ), (bf16_t*)(ws + WS_XBC)};
        pg8::gemm_phase<pg8::EpiInProj, pg8::PlainOrder, true, false>(lds, S, E, 2048, 2048);
    } SEAM(1);
    if (IN(2)) for (int rep = 0; rep < (DBL_PHASE == 2 ? 2 : 1); ++rep) {
        if (rep) xcd_barrier(bar);
        pg8::S5SOrder S{bx, (const char*)(ws + WS_AU), (const char*)(ws + WS_P)};
        pg8::EpiS5S E{(float*)(ws + WS_S5S), (long)((WS_S5S2 - WS_S5S) / 4)};
        pg8::gemm_phase<pg8::EpiS5S, pg8::S5SOrder, false, false>(lds, S, E, AUW * 2, 2048);
        if (__builtin_amdgcn_readfirstlane(tid) >= 256) __builtin_amdgcn_s_setprio(1);
        ssd::states_phase(args, lds, bx, G);
        __builtin_amdgcn_s_setprio(0);
    } SEAM(2);
    if (IN(3)) { s5_chunk_scan(args, lds); ssd::state_scan(args); } SEAM(3);
    if (IN(4)) {
        pg8::S5YOrder S{bx, (const char*)(ws + WS_AU), (const char*)(ws + WS_Q), (const char*)(ws + WS_KR)};
        pg8::EpiS5Y E{(bf16_t*)((unsigned char*)args.out + YPRE_OFF)};
        pg8::gemm_phase<pg8::EpiS5Y, pg8::S5YOrder, true, true>(lds, S, E, AUW * 2, 256);
        if (__builtin_amdgcn_readfirstlane(tid) >= 256) __builtin_amdgcn_s_setprio(1);
        ssd::out_phase(args, lds, bx, G);
        __builtin_amdgcn_s_setprio(0);
    } SEAM(4);
    if (IN(5)) {
#define P5_GLU() do { pg8::PlainOrder S; S.init(M, 1024, G, bx, (unsigned char*)args.out + YPRE_OFF, 2048, ws + WS_WGLU, 2048, 16); \
            pg8::EpiGlu E{(const bf16_t*)((unsigned char*)args.out + YPRE_OFF), (bf16_t*)(ws + WS_ZZ), args.in[I_BGLU]}; \
            pg8::gemm_phase<pg8::EpiGlu, pg8::PlainOrder, true, false>(lds, S, E, 2048, 2048); } while (0)
#define P5_PLE() do { pg8::PlainOrder S; S.init(M, 1024, G, bx, ws + WS_PB, 512, ws + WS_WPLE, 512, 4); \
            pg8::EpiBf16 E{(bf16_t*)(ws + WS_XBC), 1024}; \
            pg8::gemm_phase<pg8::EpiBf16, pg8::PlainOrder, true, false>(lds, S, E, 512, 512); } while (0)
        if (bx & 1) { P5_PLE(); P5_GLU(); } else { P5_GLU(); P5_PLE(); }
#undef P5_GLU
#undef P5_PLE
    } SEAM(5);
    if (IN(6)) for (int rep = 0; rep < (DBL_PHASE == 6 ? 2 : 1); ++rep) {
        if (rep) xcd_barrier(bar);
        pg8::PlainOrder S; S.init(M, 1024, G, bx, ws + WS_ZZ, 4096, ws + WS_WOUT, 4096, 32);
        pg8::EpiOut E{(const bf16_t*)(ws + WS_XN), (const float*)(ws + WS_RINV), (bf16_t*)(ws + WS_AU), (float*)(ws + WS_SS1)};
        pg8::gemm_phase<pg8::EpiOut, pg8::PlainOrder, true, false>(lds, S, E, 4096, 4096);
    } SEAM(6);
    if (IN(7)) {
        pg8::PlainOrder S; S.init(M, 1024, G, bx, ws + WS_AU, 2048, ws + WS_WGATE, 2048, 16);
        pg8::EpiGateFinal E{args.out, (const bf16_t*)(ws + WS_AU), (const bf16_t*)(ws + WS_XBC), (const float*)(ws + WS_SS1), (float*)(ws + WS_SS2), ctl + 16384, args.in[I_FINALW], lds + LDSCTL_OFF};
        pg8::gemm_phase<pg8::EpiGateFinal, pg8::PlainOrder, true, false>(lds, S, E, 2048, 2048);
    }
#undef IN
#undef SEAM
}

extern "C" void kernel_launch(void* const* d_in, const int* in_sizes, int n_in, void* d_out, int out_size, void* d_ws, size_t ws_size, hipStream_t stream) {
    static int grid = 0;
    if (grid == 0) {
        if (n_in != 25 || out_size != M * DM || ws_size < WS_END) { fprintf(stderr, "kernel_launch: unexpected shapes (n_in %d, out %d, ws %zu)\n", n_in, out_size, ws_size); grid = -1; return; }
        int dev = 0, cus = 0, per_cu = 0;
        if (hipGetDevice(&dev) != hipSuccess || hipDeviceGetAttribute(&cus, hipDeviceAttributeMultiprocessorCount, dev) != hipSuccess) { grid = -1; return; }
        if (hipFuncSetAttribute((const void*)mega_fwd, hipFuncAttributeMaxDynamicSharedMemorySize, LDS_BYTES) != hipSuccess) { fprintf(stderr, "hipFuncSetAttribute failed\n"); grid = -1; return; }
        if (hipOccupancyMaxActiveBlocksPerMultiprocessor(&per_cu, (const void*)mega_fwd, NTHR, LDS_BYTES) != hipSuccess || per_cu < 1) { fprintf(stderr, "occupancy query: %d\n", per_cu); per_cu = 1; }
        (void)hipGetLastError();
        if (cus < 256) { fprintf(stderr, "kernel_launch: needs >= 256 CUs\n"); grid = -1; return; }
        grid = 256;
    }
    if (grid < 0) return;
    (void)hipMemsetAsync((char*)d_ws + WS_CTL, 0, CTL_ZERO_BYTES, stream);
    Args a{};
    for (int i = 0; i < 25; ++i) a.in[i] = (const float*)d_in[i];
    a.out = (float*)d_out; a.ws = (unsigned char*)d_ws;
#if MK_N_LAUNCHES == 1
    a.ph_lo = 0; a.ph_hi = N_PHASES;
    void* kargs[] = {&a};
    hipError_t e = hipLaunchCooperativeKernel((const void*)mega_fwd, dim3(grid), dim3(NTHR), kargs, LDS_BYTES, stream);
    if (e != hipSuccess) fprintf(stderr, "cooperative launch failed: %s\n", hipGetErrorString(e));
#else
    for (int ph = 0; ph < N_PHASES; ++ph) { a.ph_lo = ph; a.ph_hi = ph + 1; hipLaunchKernelGGL(mega_fwd, dim3(grid), dim3(NTHR), LDS_BYTES, stream, a); }
#endif
}
```
